# Optimizing an MI355X kernel written in HIP

```python
import jax, jax.numpy as jnp
from jax import lax
import numpy as np

D_MODEL = 1024
BATCH = 1
SEQ = 16384
DEPTH = 1

GLA_HEADS = 4
GLA_DK = 128
GLA_DV = 256
GLA_KEY = GLA_HEADS * GLA_DK
GLA_VAL = GLA_HEADS * GLA_DV
GLA_GATE_RANK = 16
GLA_GATE_NORM = 16.0
GLA_CHUNK = 64
LRU_WIDTH = 1344
LRU_BLOCKS = 8
LRU_BW = LRU_WIDTH // LRU_BLOCKS
LRU_CONV = 4
LRU_C = 8.0
LRU_MIN_RAD = 0.9
LRU_MAX_RAD = 0.999
D_FF = 3 * D_MODEL
FFN_CONV = 3
EPS = 1e-6

D_PROJ = 2 * GLA_KEY + 2 * GLA_VAL + GLA_GATE_RANK + 2 * LRU_WIDTH + 2 * D_MODEL

kernel_name = "hybrid_gla_rglru_convffn"


def rms_norm(x, g):
    xf = x.astype(jnp.float32)
    y = xf * lax.rsqrt(jnp.mean(xf * xf, axis=-1, keepdims=True) + EPS)
    return (y * g.astype(jnp.float32)).astype(x.dtype)


def causal_dwconv(x, w, b):
    K = w.shape[0]
    S = x.shape[1]
    xp = jnp.pad(x, ((0, 0), (K - 1, 0), (0, 0)))
    y = b
    for j in range(K):
        y = y + xp[:, j:j + S] * w[j]
    return y


def gla_chunked(q, k, v, gk):
    B, S, H, dk = q.shape
    dv = v.shape[-1]
    C = GLA_CHUNK
    N = S // C
    out_dtype = v.dtype

    def to_chunks(t):
        return t.astype(jnp.float32).reshape(B, N, C, H, -1).transpose(0, 3, 1, 2, 4)

    qc = to_chunks(q) * (dk ** -0.5)
    kc = to_chunks(k)
    vc = to_chunks(v)
    b = jnp.cumsum(to_chunks(gk), axis=3)
    b_last = b[:, :, :, -1:]
    q_t = qc * jnp.exp(b)
    k_t = kc * jnp.exp(-b)
    k_s = kc * jnp.exp(b_last - b)

    mask = jnp.tril(jnp.ones((C, C), dtype=bool))
    A = jnp.einsum('bhnik,bhnjk->bhnij', q_t, k_t)
    A = jnp.where(mask, A, 0.0)
    o_intra = jnp.einsum('bhnij,bhnjv->bhniv', A, vc)

    dS = jnp.einsum('bhnck,bhncv->bhnkv', k_s, vc)
    decay = jnp.exp(b_last[:, :, :, 0])

    def step(s_prev, inp):
        d, ds = inp
        return d[..., None] * s_prev + ds, s_prev

    s0 = jnp.zeros((B, H, dk, dv), jnp.float32)
    _, s_start = lax.scan(step, s0, (jnp.moveaxis(decay, 2, 0), jnp.moveaxis(dS, 2, 0)))
    s_start = jnp.moveaxis(s_start, 0, 2)
    o_inter = jnp.einsum('bhnck,bhnkv->bhncv', q_t, s_start)

    o = o_intra + o_inter
    return o.transpose(0, 2, 3, 1, 4).reshape(B, S, H, dv).astype(out_dtype)


def rg_lru(x, w_a, b_a, w_x, b_x, a_param):
    B, S, W = x.shape
    xf = x.astype(jnp.float32)
    xb = xf.reshape(B, S, LRU_BLOCKS, LRU_BW)
    r = jax.nn.sigmoid(jnp.einsum('bsnc,ncd->bsnd', xb, w_a.astype(jnp.float32)).reshape(B, S, W) + b_a)
    i = jax.nn.sigmoid(jnp.einsum('bsnc,ncd->bsnd', xb, w_x.astype(jnp.float32)).reshape(B, S, W) + b_x)
    log_a = -LRU_C * r * jax.nn.softplus(a_param.astype(jnp.float32))
    a = jnp.exp(log_a)
    u = jnp.sqrt(-jnp.expm1(2.0 * log_a)) * (i * xf)

    def combine(c1, c2):
        a1, b1 = c1
        a2, b2 = c2
        return a1 * a2, a2 * b1 + b2

    _, h = lax.associative_scan(combine, (a, u), axis=1)
    return h.astype(x.dtype)


def setup_inputs(seed: int = 0) -> dict:
    key = jax.random.key(seed)
    ks = jax.random.split(key, 24)
    L = DEPTH

    def nrm(k, shape, fan_in):
        return jax.random.normal(k, shape, jnp.float32) * (fan_in ** -0.5)

    def gain(k, shape):
        return 1.0 + 0.02 * jax.random.normal(k, shape, jnp.float32)

    def small(k, shape):
        return 0.01 * jax.random.normal(k, shape, jnp.float32)

    x = jax.random.normal(ks[0], (BATCH, SEQ, D_MODEL), jnp.float32)
    rad = jax.random.uniform(ks[13], (L, LRU_WIDTH), jnp.float32, LRU_MIN_RAD, LRU_MAX_RAD)
    lru_a_param = jnp.log(jnp.expm1(-jnp.log(rad)))
    return {
        "x": x,
        "attn_norm": gain(ks[1], (L, D_MODEL)),
        "w_in": nrm(ks[2], (L, D_MODEL, D_PROJ), D_MODEL),
        "gla_wf2": nrm(ks[3], (L, GLA_GATE_RANK, GLA_KEY), GLA_GATE_RANK),
        "gla_bf2": small(ks[4], (L, GLA_KEY)),
        "gla_onorm": gain(ks[5], (L, GLA_DV)),
        "gla_wo": nrm(ks[6], (L, GLA_VAL, D_MODEL), GLA_VAL),
        "lru_conv_w": nrm(ks[7], (L, LRU_CONV, LRU_WIDTH), LRU_CONV),
        "lru_conv_b": small(ks[8], (L, LRU_WIDTH)),
        "lru_wa": nrm(ks[9], (L, LRU_BLOCKS, LRU_BW, LRU_BW), LRU_BW),
        "lru_ba": small(ks[10], (L, LRU_WIDTH)),
        "lru_wx": nrm(ks[11], (L, LRU_BLOCKS, LRU_BW, LRU_BW), LRU_BW),
        "lru_bx": small(ks[12], (L, LRU_WIDTH)),
        "lru_a_param": lru_a_param,
        "lru_wo": nrm(ks[14], (L, LRU_WIDTH, D_MODEL), LRU_WIDTH),
        "w_out": nrm(ks[15], (L, D_MODEL, D_MODEL), D_MODEL),
        "ffn_norm": gain(ks[16], (L, D_MODEL)),
        "ffn_wup": nrm(ks[17], (L, D_MODEL, 2 * D_FF), D_MODEL),
        "ffn_conv_w": nrm(ks[18], (L, FFN_CONV, 2 * D_FF), FFN_CONV),
        "ffn_conv_b": small(ks[19], (L, 2 * D_FF)),
        "ffn_wdown": nrm(ks[20], (L, D_FF, D_MODEL), D_FF),
        "final_norm": gain(ks[21], (D_MODEL,)),
    }


def reference(x, attn_norm, w_in, gla_wf2, gla_bf2, gla_onorm, gla_wo,
              lru_conv_w, lru_conv_b, lru_wa, lru_ba, lru_wx, lru_bx, lru_a_param, lru_wo,
              w_out, ffn_norm, ffn_wup, ffn_conv_w, ffn_conv_b, ffn_wdown, final_norm):
    B, S, _ = x.shape
    splits = np.cumsum([GLA_KEY, GLA_KEY, GLA_VAL, GLA_VAL, GLA_GATE_RANK,
                        LRU_WIDTH, LRU_WIDTH, D_MODEL])
    for l in range(DEPTH):
        h = rms_norm(x, attn_norm[l])
        p = jnp.einsum('bsd,de->bse', h, w_in[l])
        q, k, v, g, f_low, x_lru, lru_gate, gate_a, gate_b = jnp.split(p, splits, axis=-1)

        gk = jax.nn.log_sigmoid(
            (jnp.einsum('bsr,rk->bsk', f_low, gla_wf2[l]) + gla_bf2[l]).astype(jnp.float32)) / GLA_GATE_NORM
        o = gla_chunked(q.reshape(B, S, GLA_HEADS, GLA_DK),
                        k.reshape(B, S, GLA_HEADS, GLA_DK),
                        v.reshape(B, S, GLA_HEADS, GLA_DV),
                        gk.reshape(B, S, GLA_HEADS, GLA_DK))
        o = rms_norm(o, gla_onorm[l]) * jax.nn.silu(g.reshape(B, S, GLA_HEADS, GLA_DV))
        y_a = jnp.einsum('bse,ed->bsd', o.reshape(B, S, GLA_VAL), gla_wo[l])

        xc = causal_dwconv(x_lru, lru_conv_w[l], lru_conv_b[l])
        hl = rg_lru(xc, lru_wa[l], lru_ba[l], lru_wx[l], lru_bx[l], lru_a_param[l])
        y_b = jnp.einsum('bse,ed->bsd', hl * jax.nn.gelu(lru_gate, approximate=True), lru_wo[l])

        merged = jax.nn.sigmoid(gate_a) * y_a + jax.nn.sigmoid(gate_b) * y_b
        x = x + jnp.einsum('bsd,de->bse', merged, w_out[l])

        h = rms_norm(x, ffn_norm[l])
        u = jnp.einsum('bsd,df->bsf', h, ffn_wup[l])
        u = causal_dwconv(u, ffn_conv_w[l], ffn_conv_b[l])
        u_gate, u_val = jnp.split(u, 2, axis=-1)
        x = x + jnp.einsum('bsf,fd->bsd', jax.nn.gelu(u_gate, approximate=True) * u_val, ffn_wdown[l])

    return rms_norm(x, final_norm)
```

```cpp
#include <hip/hip_runtime.h>
#include <hip/hip_cooperative_groups.h>
#include <cstdio>
namespace cg = cooperative_groups;
namespace pg8 {
#define PG8_LAS __attribute__((address_space(3)))
typedef unsigned short bf16_t;
typedef short bf16x8 __attribute__((ext_vector_type(8)));
typedef float f32x4 __attribute__((ext_vector_type(4)));
typedef unsigned u32x4 __attribute__((ext_vector_type(4)));
constexpr int BM = 256, BK = 64, HALF = 128, HTB = HALF * BK * 2  , STAGE_BYTES = 8 * HTB, NXCD = 8, WGM = 8;

__host__ __device__ __forceinline__ int lds_byte(int r, int c) { const int st = (r >> 4) * 2 + (c >> 5), rr = r & 15, cc = c & 31, ob = rr * 64 + cc * 2; return st * 1024 + (ob ^ (((ob >> 9) & 1) << 5)); }
__host__ __device__ __forceinline__ void stage_rc(int b, int& R, int& C) { const int st = b / 1024, sb = b % 1024, swz = sb ^ (((sb >> 9) & 1) << 5); R = (st >> 1) * 16 + swz / 64; C = (st & 1) * 32 + (swz % 64) / 2; }
__host__ __device__ __forceinline__ int perm32(int rho) { const int n = rho >> 4, i = rho & 15; return 8 * (i >> 2) + 4 * n + (i & 3); }

struct Unit { int pm, pn; };
struct Gemm { const bf16_t* A; const bf16_t* Bt; int M, N, K; };

struct StaticOrder {
    int nM, nN, nwg, G, c;
    __host__ __device__ void init(int M, int N, int G_, int c_) { nM = M / BM; nN = N / BM; nwg = nM * nN; G = G_; c = c_; }
    __host__ __device__ bool next(int i, Unit& u) const {
        const long L = (long)i * G + c; if (L >= nwg) return false;
        int wgid = (int)L; { const int q = nwg / NXCD, r = nwg % NXCD, xcd = wgid % NXCD, off = wgid / NXCD; wgid = (xcd < r ? xcd * (q + 1) : r * (q + 1) + (xcd - r) * q) + off; }
        const int nig = WGM * nN, gid = wgid / nig, fm = gid * WGM, gsz = (nM - fm) < WGM ? (nM - fm) : WGM;
        u.pm = fm + ((wgid % nig) % gsz); u.pn = (wgid % nig) / gsz; return true;
    }
    __device__ __forceinline__ void a_ready(const Unit&) const {}
    __device__ __forceinline__ void done(const Unit&) const {}
};
__device__ __forceinline__ unsigned cvt_pk_bf16(float lo, float hi) { unsigned r; asm volatile("v_cvt_pk_bf16_f32 %0, %1, %2" : "=v"(r) : "v"(lo), "v"(hi)); return r; }
typedef float f32x2 __attribute__((ext_vector_type(2)));
template <class Epi, class Sched, bool STAMP = false>
__device__ __forceinline__ void gemm_phase(PG8_LAS unsigned char* lds, const Gemm g, const Sched& S, const Epi& E, unsigned long long* stamps) {
    const int tid = threadIdx.x, wid = __builtin_amdgcn_readfirstlane(tid >> 6), lane = tid & 63, wr = wid >> 2, wc = wid & 3, fr = lane & 15, fq = lane >> 4;
    const int K = g.K, nt = K / BK;
    int ts_lo = 0, ts_hi = 0, nts = 0; const unsigned long long rt_entry = STAMP ? (unsigned long long)wall_clock64() : 0ull;
#define PG8_STAMP() do { if (STAMP && wid == 0 && nts < 64) { const unsigned long long _c = (unsigned long long)clock64(); \
        ts_lo = (lane == nts) ? (int)(unsigned)_c : ts_lo; ts_hi = (lane == nts) ? (int)(unsigned)(_c >> 32) : ts_hi; ++nts; } } while (0)
    PG8_STAMP();
    unsigned voffA[2], voffB[2];
#pragma unroll
    for (int i = 0; i < 2; ++i) { int R, C; stage_rc(tid * 16 + i * 8192, R, C); const int Rb = Epi::PERM ? ((R & ~31) + perm32(R & 31)) : R;
        voffA[i] = (unsigned)(R * K + C) * 2u; voffB[i] = (unsigned)(Rb * K + C) * 2u; }
    const size_t kstep = (size_t)(BK * 2);
    const size_t hstep = (size_t)HALF * K * 2;
    const size_t tstep = 2 * hstep;
    const unsigned ldsw = (unsigned)wid * 1024u;
    const int aoff = lds_byte(wr * 64 + fr, fq * 8), boff = lds_byte(wc * 32 + fr, fq * 8);
#define PG8_SA(b, h) (((b) * 2 + (h)) * HTB)
#define PG8_SB(b, h) ((4 + (b) * 2 + (h)) * HTB)
#define PG8_STAGE(bufoff, gbase, voff) do { _Pragma("unroll") for (int _i = 0; _i < 2; ++_i) \
        __builtin_amdgcn_global_load_lds((const unsigned*)((const char*)(gbase) + (voff)[_i]), (PG8_LAS unsigned*)(lds + (bufoff) + ldsw + _i * 8192), 16, 0, 0); } while (0)
#define PG8_LDA(dst, b, h) do { _Pragma("unroll") for (int m = 0; m < 4; ++m) _Pragma("unroll") for (int k = 0; k < 2; ++k) dst[m][k] = *(const PG8_LAS bf16x8*)(lds + PG8_SA(b, h) + aoff + m * 2048 + k * 1024); } while (0)
#define PG8_LDB(dst, b, h) do { _Pragma("unroll") for (int n = 0; n < 2; ++n) _Pragma("unroll") for (int k = 0; k < 2; ++k) dst[n][k] = *(const PG8_LAS bf16x8*)(lds + PG8_SB(b, h) + boff + n * 2048 + k * 1024); } while (0)
#define PG8_MMA(ai, bj, At, Bt) do { __builtin_amdgcn_s_setprio(1); _Pragma("unroll") for (int m = 0; m < 4; ++m) _Pragma("unroll") for (int n = 0; n < 2; ++n) _Pragma("unroll") for (int k = 0; k < 2; ++k) \
        acc[ai][bj][m][n] = __builtin_amdgcn_mfma_f32_16x16x32_bf16(Bt[n][k], At[m][k], acc[ai][bj][m][n], 0, 0, 0); __builtin_amdgcn_s_setprio(0); } while (0)
#define PG8_WAIT_V(n) asm volatile("s_waitcnt vmcnt(" #n ")" ::: "memory")
#define PG8_WAIT_L(n) asm volatile("s_waitcnt lgkmcnt(" #n ")" ::: "memory")
#define PG8_BAR __builtin_amdgcn_s_barrier()
#define PG8_SCHED __builtin_amdgcn_sched_barrier(0)
    Unit cur, nxt; int ui = 0;
    if (!S.next(0, cur)) return;
    f32x4 acc[2][2][4][2];
#pragma unroll
    for (int a = 0; a < 2; ++a)
#pragma unroll
        for (int b = 0; b < 2; ++b)
#pragma unroll
            for (int m = 0; m < 4; ++m)
#pragma unroll
                for (int n = 0; n < 2; ++n) acc[a][b][m][n] = (f32x4){0.f, 0.f, 0.f, 0.f};
    bf16x8 At[4][2], B0[2][2], B1[2][2];
    const char* cA = (const char*)g.A + (size_t)cur.pm * tstep; const char* cB = (const char*)g.Bt + (size_t)cur.pn * tstep;
    S.a_ready(cur);
    PG8_STAGE(PG8_SB(0, 0), cB, voffB); PG8_STAGE(PG8_SA(0, 0), cA, voffA); PG8_STAGE(PG8_SB(0, 1), cB + hstep, voffB); PG8_STAGE(PG8_SA(0, 1), cA + hstep, voffA);
    if (wr == 1) PG8_BAR;
    PG8_WAIT_V(4); PG8_BAR;
    PG8_STAGE(PG8_SB(1, 0), cB + kstep, voffB); PG8_STAGE(PG8_SA(1, 0), cA + kstep, voffA); PG8_STAGE(PG8_SB(1, 1), cB + hstep + kstep, voffB);
    PG8_WAIT_V(6); PG8_BAR;
    PG8_STAMP();
    for (;;) {
        const bool has_next = S.next(ui + 1, nxt);
        const char* nA = has_next ? (const char*)g.A + (size_t)nxt.pm * tstep : cA; const char* nB = has_next ? (const char*)g.Bt + (size_t)nxt.pn * tstep : cB;
        for (int t = 0; t < nt; t += 2) {
            const bool last = (t == nt - 2);
            const char* a1 = cA + (size_t)(t + 1) * kstep;
            const char* a2 = last ? nA : cA + (size_t)(t + 2) * kstep; const char* b2 = last ? nB : cB + (size_t)(t + 2) * kstep;
            const char* a3 = a2 + kstep; const char* b3 = b2 + kstep;
            if (last && has_next) S.a_ready(nxt);
            PG8_LDB(B0, 0, 0); PG8_SCHED; PG8_LDA(At, 0, 0); PG8_STAGE(PG8_SA(1, 1), a1 + hstep, voffA);
            PG8_WAIT_L(8); PG8_BAR; PG8_WAIT_L(0); PG8_MMA(0, 0, At, B0); PG8_BAR; PG8_SCHED;
            PG8_LDB(B1, 0, 1); PG8_STAGE(PG8_SB(0, 0), b2, voffB);
            PG8_BAR; PG8_WAIT_L(0); PG8_MMA(0, 1, At, B1); PG8_BAR;
            PG8_LDA(At, 0, 1); PG8_STAGE(PG8_SA(0, 0), a2, voffA);
            PG8_BAR; PG8_WAIT_L(0); PG8_MMA(1, 0, At, B0); PG8_BAR; PG8_SCHED;
            PG8_STAGE(PG8_SB(0, 1), b2 + hstep, voffB);
            PG8_WAIT_V(6); PG8_BAR; PG8_MMA(1, 1, At, B1); PG8_BAR;
            PG8_LDB(B0, 1, 0); PG8_SCHED; PG8_LDA(At, 1, 0); PG8_STAGE(PG8_SA(0, 1), a2 + hstep, voffA);
            PG8_WAIT_L(8); PG8_BAR; PG8_WAIT_L(0); PG8_MMA(0, 0, At, B0); PG8_BAR; PG8_SCHED;
            PG8_LDB(B1, 1, 1); PG8_STAGE(PG8_SB(1, 0), b3, voffB);
            PG8_BAR; PG8_WAIT_L(0); PG8_MMA(0, 1, At, B1); PG8_BAR;
            PG8_LDA(At, 1, 1); PG8_STAGE(PG8_SA(1, 0), a3, voffA);
            PG8_BAR; PG8_WAIT_L(0); PG8_MMA(1, 0, At, B0); PG8_BAR; PG8_SCHED;
            PG8_STAGE(PG8_SB(1, 1), b3 + hstep, voffB);
            PG8_WAIT_V(6); PG8_BAR; PG8_MMA(1, 1, At, B1); PG8_BAR;
        }
        PG8_STAMP();
        if constexpr (!Epi::AFTER_DRAIN) { E(acc, cur, wr, wc, fr, fq); S.done(cur); }
        PG8_STAMP();
        if (!has_next) break;
#pragma unroll
        for (int a = 0; a < 2; ++a)
#pragma unroll
            for (int b = 0; b < 2; ++b)
#pragma unroll
                for (int m = 0; m < 4; ++m)
#pragma unroll
                    for (int n = 0; n < 2; ++n) acc[a][b][m][n] = (f32x4){0.f, 0.f, 0.f, 0.f};
        cur = nxt; cA = nA; cB = nB; ++ui;
    }
    PG8_WAIT_V(0);
    if (wr == 0) PG8_BAR;
    PG8_BAR;
    if constexpr (Epi::AFTER_DRAIN) { E.fused(acc, cur, wr, wc, fr, fq, lds, wid, lane); S.done(cur); }
    PG8_STAMP();
    if (STAMP && wid == 0) { stamps[lane] = lane < nts ? (((unsigned long long)(unsigned)ts_hi << 32) | (unsigned)ts_lo) : 0ull;
        if (lane == 62) stamps[62] = rt_entry; if (lane == 63) stamps[63] = (unsigned long long)wall_clock64(); }
#undef PG8_STAMP
#undef PG8_SA
#undef PG8_SB
#undef PG8_STAGE
#undef PG8_LDA
#undef PG8_LDB
#undef PG8_MMA
#undef PG8_WAIT_V
#undef PG8_WAIT_L
#undef PG8_BAR
#undef PG8_SCHED
}
}

typedef pg8::bf16_t bf16_t;
typedef pg8::f32x4 f32x4;
constexpr int SEQ = 16384, DM = 1024, NP = 7936, LW = 1344, LWP = 1408, DFF = 3072;
constexpr size_t MiB = (size_t)1 << 20;
constexpr size_t WS_WUP = 0, WS_WDOWN = 12 * MiB, WS_WOUT = 18 * MiB, WS_GLAWO = 20 * MiB, WS_LRUWO = 22 * MiB, WS_MISC = 25 * MiB, WS_WIN = 26 * MiB;
constexpr size_t WS_Q = 42 * MiB, WS_K = 58 * MiB, WS_V = 74 * MiB, WS_G = 106 * MiB, WS_XL = 138 * MiB, WS_GG = 180 * MiB, WS_SA = 222 * MiB, WS_FLOW = 254 * MiB, WS_ROWSQ = 255 * MiB;
constexpr size_t WS_HB = WS_Q;
constexpr size_t WS_MERGED = WS_XL;
constexpr size_t WS_X1B = 20 * MiB;
constexpr size_t WS_U = 52 * MiB;
constexpr size_t WS_HSAVE = 148 * MiB;
constexpr size_t WS_ACT = 150 * MiB;
constexpr size_t OUT_H1 = 0, OUT_SB = 32 * MiB, OUT_YAS = 0;
constexpr int LDS_BYTES = 160 * 1024;

struct Params { const float* in[22]; float* out; unsigned char* ws; };

__device__ __forceinline__ float bf2f(bf16_t b) { return __uint_as_float(((unsigned)b) << 16); }
__device__ __forceinline__ void st4(bf16_t* p, f32x4 a) { uint2 w; w.x = pg8::cvt_pk_bf16(a[0], a[1]); w.y = pg8::cvt_pk_bf16(a[2], a[3]); *(uint2*)p = w; }
__device__ __forceinline__ f32x4 ld4(const bf16_t* p) { const uint2 w = *(const uint2*)p; f32x4 r; r[0] = __uint_as_float(w.x << 16); r[1] = __uint_as_float(w.x & 0xffff0000u); r[2] = __uint_as_float(w.y << 16); r[3] = __uint_as_float(w.y & 0xffff0000u); return r; }
__device__ __forceinline__ float sigm(float x) { return 1.f / (1.f + __expf(-x)); }
__device__ __forceinline__ float gelu_t(float x) { const float y = 1.5957691216057308f * (x + 0.044715f * x * x * x); return x / (1.f + __expf(-y)); }
__device__ __forceinline__ float wave_sum(float s) {
#pragma unroll
    for (int o = 32; o >= 1; o >>= 1) s += __shfl_xor(s, o);
    return s;
}

__device__ void rmsnorm_rows_bf16(const float* x, const float* g, bf16_t* out) {
    const int wave = threadIdx.x >> 6, lane = threadIdx.x & 63;
    for (int row = blockIdx.x * 8 + wave; row < SEQ; row += gridDim.x * 8) {
        const float* xr = x + (size_t)row * DM; f32x4 v[4]; float ss = 0.f;
#pragma unroll
        for (int i = 0; i < 4; ++i) { v[i] = *(const f32x4*)(xr + i * 256 + lane * 4); ss += v[i][0] * v[i][0] + v[i][1] * v[i][1] + v[i][2] * v[i][2] + v[i][3] * v[i][3]; }
        ss = wave_sum(ss);
        const float r = rsqrtf(ss * (1.0f / DM) + 1e-6f);
#pragma unroll
        for (int i = 0; i < 4; ++i) { const f32x4 gv = *(const f32x4*)(g + i * 256 + lane * 4); st4(out + (size_t)row * DM + i * 256 + lane * 4, v[i] * r * gv); }
    }
}
__device__ void rmsnorm_rows_inplace(float* x, const float* g) {
    const int wave = threadIdx.x >> 6, lane = threadIdx.x & 63;
    for (int row = blockIdx.x * 8 + wave; row < SEQ; row += gridDim.x * 8) {
        float* xr = x + (size_t)row * DM; f32x4 v[4]; float ss = 0.f;
#pragma unroll
        for (int i = 0; i < 4; ++i) { v[i] = *(const f32x4*)(xr + i * 256 + lane * 4); ss += v[i][0] * v[i][0] + v[i][1] * v[i][1] + v[i][2] * v[i][2] + v[i][3] * v[i][3]; }
        ss = wave_sum(ss);
        const float r = rsqrtf(ss * (1.0f / DM) + 1e-6f);
#pragma unroll
        for (int i = 0; i < 4; ++i) { const f32x4 gv = *(const f32x4*)(g + i * 256 + lane * 4); *(f32x4*)(xr + i * 256 + lane * 4) = v[i] * r * gv; }
    }
}
__device__ __forceinline__ int colmap_win(int n) {
    if (n < 3072) return n;
    if (n < 4096) return 5776 + (n - 3072);
    if (n < 5120) return 6800 + (n - 4096);
    if (n < 6464) return 3088 + (n - 5120);
    if (n < 7808) return 4432 + (n - 6464);
    if (n < 7824) return 3072 + (n - 7808);
    return -1;
}
template <int MODE>
__device__ void transpose_w(const float* src, int srcK, int srcLd, int srcNvalid, bf16_t* dst, int dstN, int dstK, const float* rowscale, float* tile) {
    const int tk = dstK / 64, tn = dstN / 64;
    for (int tIdx = blockIdx.x; tIdx < tk * tn; tIdx += gridDim.x) {
        const int k0 = (tIdx % tk) * 64, n0 = (tIdx / tk) * 64;
        const int lane = threadIdx.x & 63, i = threadIdx.x >> 6;
        const int n = n0 + lane; const int sc = MODE == 1 ? colmap_win(n) : (n < srcNvalid ? n : -1);
        for (int kk = i; kk < 64; kk += 8) { const int k = k0 + kk; float val = 0.f; if (sc >= 0 && k < srcK) { val = src[(size_t)k * srcLd + sc]; if (rowscale) val *= rowscale[k]; } tile[kk * 65 + lane] = val; }
        __syncthreads();
        const int nl = threadIdx.x >> 3, kg = threadIdx.x & 7;
        float f[8];
#pragma unroll
        for (int j = 0; j < 8; ++j) f[j] = tile[(kg * 8 + j) * 65 + nl];
        uint4 w; w.x = pg8::cvt_pk_bf16(f[0], f[1]); w.y = pg8::cvt_pk_bf16(f[2], f[3]); w.z = pg8::cvt_pk_bf16(f[4], f[5]); w.w = pg8::cvt_pk_bf16(f[6], f[7]);
        *(uint4*)(dst + (size_t)(n0 + nl) * dstK + k0 + kg * 8) = w;
        __syncthreads();
    }
}

template <class F> struct EpiGen {
    static constexpr bool PERM = false, AFTER_DRAIN = false; F f;
    __device__ __forceinline__ void operator()(const f32x4 (&acc)[2][2][4][2], const pg8::Unit& u, int wr, int wc, int fr, int fq) const {
#pragma unroll
        for (int ai = 0; ai < 2; ++ai)
#pragma unroll
            for (int m = 0; m < 4; ++m) { const int row = u.pm * 256 + ai * 128 + wr * 64 + m * 16 + fr;
#pragma unroll
                for (int bj = 0; bj < 2; ++bj)
#pragma unroll
                    for (int n = 0; n < 2; ++n) f(row, u.pn * 256 + bj * 128 + wc * 32 + n * 16 + 4 * fq, acc[ai][bj][m][n]); }
    }
};
struct F1 {
    bf16_t *q, *k, *v, *g, *sA, *sB, *xl, *gg; float* flow;
    __device__ __forceinline__ void operator()(int row, int col, f32x4 a) const {
        if (col < 3072) {
            bf16_t* base; int ld, c;
            if (col < 512) { base = q; ld = 512; c = col; } else if (col < 1024) { base = k; ld = 512; c = col - 512; } else if (col < 2048) { base = v; ld = 1024; c = col - 1024; } else { base = g; ld = 1024; c = col - 2048; }
            st4(base + (size_t)row * ld + c, a);
        } else if (col < 5120) {
            f32x4 s; s[0] = sigm(a[0]); s[1] = sigm(a[1]); s[2] = sigm(a[2]); s[3] = sigm(a[3]);
            if (col < 4096) st4(sA + (size_t)row * DM + (col - 3072), s); else st4(sB + (size_t)row * DM + (col - 4096), s);
        } else if (col < 6464) { st4(xl + (size_t)row * LW + (col - 5120), a);
        } else if (col < 7808) { f32x4 s; s[0] = gelu_t(a[0]); s[1] = gelu_t(a[1]); s[2] = gelu_t(a[2]); s[3] = gelu_t(a[3]); st4(gg + (size_t)row * LW + (col - 6464), s);
        } else if (col < 7824) { *(f32x4*)(flow + (size_t)row * 16 + (col - 7808)) = a; }
    }
};
struct F2 {
    const bf16_t* sA; bf16_t* yas;
    __device__ __forceinline__ void operator()(int row, int col, f32x4 a) const { const size_t o = (size_t)row * DM + col; st4(yas + o, ld4(sA + o) * a); }
};
struct F3 {
    const bf16_t *sB, *yas; bf16_t* merged;
    __device__ __forceinline__ void operator()(int row, int col, f32x4 a) const { const size_t o = (size_t)row * DM + col; st4(merged + o, ld4(yas + o) + ld4(sB + o) * a); }
};
struct E4 {
    static constexpr bool PERM = false, AFTER_DRAIN = false;
    const float* x; float* x1; bf16_t* x1b; float* rowsq;
    __device__ __forceinline__ void operator()(const f32x4 (&acc)[2][2][4][2], const pg8::Unit& u, int wr, int wc, int fr, int fq) const {
#pragma unroll
        for (int ai = 0; ai < 2; ++ai)
#pragma unroll
            for (int m = 0; m < 4; ++m) { const int row = u.pm * 256 + ai * 128 + wr * 64 + m * 16 + fr; float ss = 0.f;
#pragma unroll
                for (int bj = 0; bj < 2; ++bj)
#pragma unroll
                    for (int n = 0; n < 2; ++n) { const size_t o = (size_t)row * DM + u.pn * 256 + bj * 128 + wc * 32 + n * 16 + 4 * fq;
                        const f32x4 r = *(const f32x4*)(x + o) + acc[ai][bj][m][n]; *(f32x4*)(x1 + o) = r; st4(x1b + o, r); ss += r[0] * r[0] + r[1] * r[1] + r[2] * r[2] + r[3] * r[3]; }
                ss += __shfl_xor(ss, 16); ss += __shfl_xor(ss, 32);
                if (fq == 0) atomicAdd(rowsq + row, ss); }
    }
};
struct F5 {
    const float* rowsq; bf16_t* u; int row0;
    __device__ __forceinline__ void operator()(int row, int col, f32x4 a) const { const float r = rsqrtf(rowsq[row0 + row] * (1.0f / DM) + 1e-6f); st4(u + (size_t)row * (2 * DFF) + col, a * r); }
};
struct F6 {
    float* x1;
    __device__ __forceinline__ void operator()(int row, int col, f32x4 a) const { float* p = x1 + (size_t)row * DM + col; *(f32x4*)p = *(const f32x4*)p + a; }
};

__device__ void gla_naive(const Params& P, float* sm) {
    if (blockIdx.x >= 4) return;
    const int h = blockIdx.x, tid = threadIdx.x;
    const bf16_t* q = (const bf16_t*)(P.ws + WS_Q); const bf16_t* k = (const bf16_t*)(P.ws + WS_K); const bf16_t* v = (const bf16_t*)(P.ws + WS_V); bf16_t* g = (bf16_t*)(P.ws + WS_G);
    const float* flow = (const float*)(P.ws + WS_FLOW); const float* wf2 = P.in[3]; const float* bf2 = P.in[4]; const float* onorm = P.in[5];
    float* al = sm; float* qs = sm + 128; float* ks = sm + 256; float* red = sm + 384;
    float St[128];
#pragma unroll
    for (int i = 0; i < 128; ++i) St[i] = 0.f;
    float wcol[16]; float bcol = 0.f;
    if (tid < 128) {
#pragma unroll
        for (int r = 0; r < 16; ++r) wcol[r] = wf2[r * 512 + h * 128 + tid];
        bcol = bf2[h * 128 + tid];
    } else {
#pragma unroll
        for (int r = 0; r < 16; ++r) wcol[r] = 0.f;
    }
    const float on = tid < 256 ? onorm[tid] : 0.f;
    for (int t = 0; t < SEQ; ++t) {
        if (tid < 128) {
            float z = bcol;
#pragma unroll
            for (int r = 0; r < 16; ++r) z += flow[(size_t)t * 16 + r] * wcol[r];
            const float ls = fminf(z, 0.f) - log1pf(__expf(-fabsf(z)));
            al[tid] = __expf(ls * (1.0f / 16.0f));
            qs[tid] = bf2f(q[(size_t)t * 512 + h * 128 + tid]) * 0.08838834764831845f;
            ks[tid] = bf2f(k[(size_t)t * 512 + h * 128 + tid]);
        }
        __syncthreads();
        float o = 0.f;
        if (tid < 256) {
            const float vv = bf2f(v[(size_t)t * 1024 + h * 256 + tid]);
#pragma unroll
            for (int i = 0; i < 128; ++i) { St[i] = al[i] * St[i] + ks[i] * vv; o += qs[i] * St[i]; }
        }
        const float s2 = wave_sum(o * o);
        if ((tid & 63) == 0) red[tid >> 6] = s2;
        __syncthreads();
        if (tid < 256) {
            const float tot = red[0] + red[1] + red[2] + red[3];
            const float rr = rsqrtf(tot * (1.0f / 256.0f) + 1e-6f);
            const size_t gi = (size_t)t * 1024 + h * 256 + tid;
            const float gv = bf2f(g[gi]);
            const float res = o * rr * on * (gv * sigm(gv));
            g[gi] = (bf16_t)(pg8::cvt_pk_bf16(res, 0.f) & 0xffffu);
        }
    }
}
__device__ void lru_naive(const Params& P, float* sm) {
    if (blockIdx.x >= 8) return;
    const int j = blockIdx.x, tid = threadIdx.x; const bool act = tid < 168; const int ch = j * 168 + (act ? tid : 0);
    const bf16_t* xl = (const bf16_t*)(P.ws + WS_XL); const bf16_t* gg = (const bf16_t*)(P.ws + WS_GG); bf16_t* hb = (bf16_t*)(P.ws + WS_HB);
    const float* cw = P.in[7]; const float* cb = P.in[8]; const float* wa = P.in[9] + (size_t)j * 168 * 168; const float* ba = P.in[10]; const float* wx = P.in[11] + (size_t)j * 168 * 168; const float* bx = P.in[12]; const float* ap = P.in[13];
    const float w0 = cw[ch], w1 = cw[LW + ch], w2 = cw[2 * LW + ch], w3 = cw[3 * LW + ch], b0 = cb[ch], bav = ba[ch], bxv = bx[ch];
    const float apv = ap[ch]; const float sp = fmaxf(apv, 0.f) + log1pf(__expf(-fabsf(apv)));
    float x3 = 0.f, x2 = 0.f, x1 = 0.f, hs = 0.f;
    float* xcs = sm;
    for (int t = 0; t < SEQ; ++t) {
        float xc = 0.f;
        if (act) { const float xv = bf2f(xl[(size_t)t * LW + ch]); xc = b0 + w0 * x3 + w1 * x2 + w2 * x1 + w3 * xv; x3 = x2; x2 = x1; x1 = xv; xcs[tid] = xc; }
        __syncthreads();
        if (act) {
            float ra = bav, ri = bxv;
            for (int c = 0; c < 168; ++c) { const float xv = xcs[c]; ra += xv * wa[c * 168 + tid]; ri += xv * wx[c * 168 + tid]; }
            const float r = sigm(ra), ig = sigm(ri);
            const float la = -8.0f * r * sp; const float a = __expf(la);
            const float uu = sqrtf(-expm1f(2.0f * la)) * (ig * xc);
            hs = a * hs + uu;
            const float res = hs * bf2f(gg[(size_t)t * LW + ch]);
            hb[(size_t)t * LWP + ch] = (bf16_t)(pg8::cvt_pk_bf16(res, 0.f) & 0xffffu);
        } else if (tid < 176) { hb[(size_t)t * LWP + LW + j * 8 + (tid - 168)] = 0; }
        __syncthreads();
    }
}
__device__ void conv_geglu_half(const Params& P, int half) {
    const bf16_t* ub = (const bf16_t*)(P.ws + WS_U); bf16_t* hsave = (bf16_t*)(P.ws + WS_HSAVE); bf16_t* actb = (bf16_t*)(P.ws + WS_ACT);
    const float* cw = P.in[18]; const float* cb = P.in[19];
    const int nthr = gridDim.x * blockDim.x, gtid = blockIdx.x * blockDim.x + threadIdx.x;
    for (int idx = gtid; idx < 8192 * 384; idx += nthr) {
        const int tl = idx / 384, f = (idx % 384) * 8;
        float og[8], ov[8];
#pragma unroll
        for (int i = 0; i < 8; ++i) { og[i] = cb[f + i]; ov[i] = cb[DFF + f + i]; }
#pragma unroll
        for (int d = 0; d < 3; ++d) {
            const int r = tl - 2 + d; const bf16_t* rowp = nullptr;
            if (r >= 0) rowp = ub + (size_t)r * (2 * DFF); else if (half == 1) rowp = hsave + (size_t)(2 + r) * (2 * DFF);
            if (rowp) {
                const uint4 a = *(const uint4*)(rowp + f), b = *(const uint4*)(rowp + DFF + f);
                const unsigned aw[4] = {a.x, a.y, a.z, a.w}, bw[4] = {b.x, b.y, b.z, b.w};
#pragma unroll
                for (int i = 0; i < 4; ++i) {
                    og[2 * i] += cw[d * 2 * DFF + f + 2 * i] * __uint_as_float(aw[i] << 16); og[2 * i + 1] += cw[d * 2 * DFF + f + 2 * i + 1] * __uint_as_float(aw[i] & 0xffff0000u);
                    ov[2 * i] += cw[d * 2 * DFF + DFF + f + 2 * i] * __uint_as_float(bw[i] << 16); ov[2 * i + 1] += cw[d * 2 * DFF + DFF + f + 2 * i + 1] * __uint_as_float(bw[i] & 0xffff0000u);
                }
            }
        }
        uint4 w; w.x = pg8::cvt_pk_bf16(gelu_t(og[0]) * ov[0], gelu_t(og[1]) * ov[1]); w.y = pg8::cvt_pk_bf16(gelu_t(og[2]) * ov[2], gelu_t(og[3]) * ov[3]);
        w.z = pg8::cvt_pk_bf16(gelu_t(og[4]) * ov[4], gelu_t(og[5]) * ov[5]); w.w = pg8::cvt_pk_bf16(gelu_t(og[6]) * ov[6], gelu_t(og[7]) * ov[7]);
        *(uint4*)(actb + (size_t)(half * 8192 + tl) * DFF + f) = w;
    }
    if (half == 0) for (int i = gtid; i < 2 * 2 * DFF; i += nthr) hsave[i] = ub[(size_t)8190 * (2 * DFF) + i];
}

template <class Epi> __device__ __forceinline__ void run_gemm(PG8_LAS unsigned char* lds, const bf16_t* A, const bf16_t* Bt, int M, int N, int K, const Epi& E) {
    pg8::Gemm g{A, Bt, M, N, K}; pg8::StaticOrder S; S.init(M, N, (int)gridDim.x, (int)blockIdx.x);
    pg8::gemm_phase<Epi, pg8::StaticOrder, false>(lds, g, S, E, nullptr);
}

__global__ void __launch_bounds__(512, 2) fwd_megakernel(Params P) {
    extern __shared__ __attribute__((aligned(16))) unsigned char smem[];
    cg::grid_group grid = cg::this_grid();
    PG8_LAS unsigned char* lds = (PG8_LAS unsigned char*)smem;
    unsigned char* ws = P.ws; unsigned char* ob = (unsigned char*)P.out;
    bf16_t* h1 = (bf16_t*)(ob + OUT_H1); bf16_t* sB = (bf16_t*)(ob + OUT_SB); bf16_t* yas = (bf16_t*)(ob + OUT_YAS);
    bf16_t* Wup = (bf16_t*)(ws + WS_WUP); bf16_t* Wdown = (bf16_t*)(ws + WS_WDOWN); bf16_t* Wout = (bf16_t*)(ws + WS_WOUT); bf16_t* Wglao = (bf16_t*)(ws + WS_GLAWO); bf16_t* Wlruo = (bf16_t*)(ws + WS_LRUWO); bf16_t* Win = (bf16_t*)(ws + WS_WIN);
    float* rowsq = (float*)(ws + WS_ROWSQ);

    rmsnorm_rows_bf16(P.in[0], P.in[1], h1);
    transpose_w<1>(P.in[2], DM, 7824, 7824, Win, NP, DM, nullptr, (float*)smem);
    transpose_w<0>(P.in[6], 1024, 1024, 1024, Wglao, 1024, 1024, nullptr, (float*)smem);
    transpose_w<0>(P.in[14], LW, 1024, 1024, Wlruo, 1024, LWP, nullptr, (float*)smem);
    transpose_w<0>(P.in[15], 1024, 1024, 1024, Wout, 1024, 1024, nullptr, (float*)smem);
    transpose_w<0>(P.in[17], 1024, 2 * DFF, 2 * DFF, Wup, 2 * DFF, 1024, P.in[16], (float*)smem);
    transpose_w<0>(P.in[20], DFF, 1024, 1024, Wdown, 1024, DFF, nullptr, (float*)smem);
    for (int i = blockIdx.x * blockDim.x + threadIdx.x; i < SEQ; i += gridDim.x * blockDim.x) rowsq[i] = 0.f;
    grid.sync();
    { EpiGen<F1> E{F1{(bf16_t*)(ws + WS_Q), (bf16_t*)(ws + WS_K), (bf16_t*)(ws + WS_V), (bf16_t*)(ws + WS_G), (bf16_t*)(ws + WS_SA), sB, (bf16_t*)(ws + WS_XL), (bf16_t*)(ws + WS_GG), (float*)(ws + WS_FLOW)}};
      run_gemm(lds, h1, Win, SEQ, NP, DM, E); }
    grid.sync();
    gla_naive(P, (float*)smem);
    grid.sync();
    lru_naive(P, (float*)smem);
    grid.sync();
    { EpiGen<F2> E{F2{(const bf16_t*)(ws + WS_SA), yas}}; run_gemm(lds, (const bf16_t*)(ws + WS_G), Wglao, SEQ, DM, DM, E); }
    { EpiGen<F3> E{F3{sB, yas, (bf16_t*)(ws + WS_MERGED)}}; run_gemm(lds, (const bf16_t*)(ws + WS_HB), Wlruo, SEQ, DM, LWP, E); }
    grid.sync();
    { E4 E{P.in[0], P.out, (bf16_t*)(ws + WS_X1B), rowsq}; run_gemm(lds, (const bf16_t*)(ws + WS_MERGED), Wout, SEQ, DM, DM, E); }
    grid.sync();
    for (int half = 0; half < 2; ++half) {
        { EpiGen<F5> E{F5{rowsq, (bf16_t*)(ws + WS_U), half * 8192}}; run_gemm(lds, (const bf16_t*)(ws + WS_X1B) + (size_t)half * 8192 * DM, Wup, 8192, 2 * DFF, DM, E); }
        grid.sync();
        conv_geglu_half(P, half);
        grid.sync();
    }
    { EpiGen<F6> E{F6{P.out}}; run_gemm(lds, (const bf16_t*)(ws + WS_ACT), Wdown, SEQ, DM, DFF, E); }
    grid.sync();
    rmsnorm_rows_inplace(P.out, P.in[21]);
}

extern "C" void kernel_launch(void* const* d_in, const int* in_sizes, int n_in, void* d_out, int out_size, void* d_ws, size_t ws_size, hipStream_t stream) {
    static int grid_blocks = 0;
    if (grid_blocks == 0) {
        int dev = 0, cus = 0, per_cu = 0;
        hipGetDevice(&dev);
        hipDeviceGetAttribute(&cus, hipDeviceAttributeMultiprocessorCount, dev);
        if (hipFuncSetAttribute((const void*)fwd_megakernel, hipFuncAttributeMaxDynamicSharedMemorySize, LDS_BYTES) != hipSuccess) { fprintf(stderr, "hipFuncSetAttribute failed\n"); grid_blocks = -1; return; }
        if (hipOccupancyMaxActiveBlocksPerMultiprocessor(&per_cu, (const void*)fwd_megakernel, 512, LDS_BYTES) != hipSuccess || per_cu < 1) { fprintf(stderr, "occupancy query: %d\n", per_cu); per_cu = 1; }
        (void)hipGetLastError();
        grid_blocks = cus * per_cu;
        if (n_in != 22 || ws_size < 256 * MiB) { fprintf(stderr, "unexpected n_in %d / ws_size %zu\n", n_in, ws_size); }
    }
    if (grid_blocks < 0) return;
    Params p{};
    for (int i = 0; i < 22; ++i) p.in[i] = (const float*)d_in[i];
    p.out = (float*)d_out; p.ws = (unsigned char*)d_ws;
    void* args[] = {&p};
    hipError_t e = hipLaunchCooperativeKernel((const void*)fwd_megakernel, dim3(grid_blocks), dim3(512), args, LDS_BYTES, stream);
    if (e != hipSuccess) fprintf(stderr, "cooperative launch failed: %s (grid %d)\n", hipGetErrorString(e), grid_blocks);
}
```

```cpp
#include <hip/hip_runtime.h>
#include <hip/hip_cooperative_groups.h>
#include <cstdio>
namespace cg = cooperative_groups;
namespace pg8 {
#define PG8_LAS __attribute__((address_space(3)))
typedef unsigned short bf16_t;
typedef short bf16x8 __attribute__((ext_vector_type(8)));
typedef float f32x4 __attribute__((ext_vector_type(4)));
typedef unsigned u32x4 __attribute__((ext_vector_type(4)));
constexpr int BM = 256, BK = 64, HALF = 128, HTB = HALF * BK * 2  , STAGE_BYTES = 8 * HTB, NXCD = 8, WGM = 8;

__host__ __device__ __forceinline__ int lds_byte(int r, int c) { const int st = (r >> 4) * 2 + (c >> 5), rr = r & 15, cc = c & 31, ob = rr * 64 + cc * 2; return st * 1024 + (ob ^ (((ob >> 9) & 1) << 5)); }
__host__ __device__ __forceinline__ void stage_rc(int b, int& R, int& C) { const int st = b / 1024, sb = b % 1024, swz = sb ^ (((sb >> 9) & 1) << 5); R = (st >> 1) * 16 + swz / 64; C = (st & 1) * 32 + (swz % 64) / 2; }
__host__ __device__ __forceinline__ int perm32(int rho) { const int n = rho >> 4, i = rho & 15; return 8 * (i >> 2) + 4 * n + (i & 3); }

struct Unit { int pm, pn; };
struct Gemm { const bf16_t* A; const bf16_t* Bt; int M, N, K; int a_tile_rows; };

struct StaticOrder {
    int nM, nN, nwg, G, c;
    __host__ __device__ void init(int M, int N, int G_, int c_) { nM = M / BM; nN = N / BM; nwg = nM * nN; G = G_; c = c_; }
    __host__ __device__ bool next(int i, Unit& u) const {
        const long L = (long)i * G + c; if (L >= nwg) return false;
        int wgid = (int)L; { const int q = nwg / NXCD, r = nwg % NXCD, xcd = wgid % NXCD, off = wgid / NXCD; wgid = (xcd < r ? xcd * (q + 1) : r * (q + 1) + (xcd - r) * q) + off; }
        const int nig = WGM * nN, gid = wgid / nig, fm = gid * WGM, gsz = (nM - fm) < WGM ? (nM - fm) : WGM;
        u.pm = fm + ((wgid % nig) % gsz); u.pn = (wgid % nig) / gsz; return true;
    }
    __device__ __forceinline__ void a_ready(const Unit&) const {}
    __device__ __forceinline__ void done(const Unit&) const {}
};
__device__ __forceinline__ unsigned cvt_pk_bf16(float lo, float hi) { unsigned r; asm volatile("v_cvt_pk_bf16_f32 %0, %1, %2" : "=v"(r) : "v"(lo), "v"(hi)); return r; }
typedef float f32x2 __attribute__((ext_vector_type(2)));
template <class Epi, class Sched, bool STAMP = false>
__device__ __forceinline__ void gemm_phase(PG8_LAS unsigned char* lds, const Gemm g, const Sched& S, const Epi& E, unsigned long long* stamps) {
    const int tid = threadIdx.x, wid = __builtin_amdgcn_readfirstlane(tid >> 6), lane = tid & 63, wr = wid >> 2, wc = wid & 3, fr = lane & 15, fq = lane >> 4;
    const int K = g.K, nt = K / BK;
    int ts_lo = 0, ts_hi = 0, nts = 0; const unsigned long long rt_entry = STAMP ? (unsigned long long)wall_clock64() : 0ull;
#define PG8_STAMP() do { if (STAMP && wid == 0 && nts < 64) { const unsigned long long _c = (unsigned long long)clock64(); \
        ts_lo = (lane == nts) ? (int)(unsigned)_c : ts_lo; ts_hi = (lane == nts) ? (int)(unsigned)(_c >> 32) : ts_hi; ++nts; } } while (0)
    PG8_STAMP();
    unsigned voffA[2], voffB[2];
#pragma unroll
    for (int i = 0; i < 2; ++i) { int R, C; stage_rc(tid * 16 + i * 8192, R, C); const int Rb = Epi::PERM ? ((R & ~31) + perm32(R & 31)) : R;
        const int Ra = Epi::APERM ? ((R & 64) + 4 * (R & 15) + ((R >> 4) & 3)) : R;
        voffA[i] = (unsigned)(Ra * K + C) * 2u; voffB[i] = (unsigned)(Rb * K + C) * 2u; }
    const size_t kstep = (size_t)(BK * 2);
    const size_t hstep = (size_t)HALF * K * 2;
    const size_t tstep = 2 * hstep; const size_t tstepA = (size_t)g.a_tile_rows * K * 2;
    const unsigned ldsw = (unsigned)wid * 1024u;
    const int aoff = lds_byte(wr * 64 + fr, fq * 8), boff = lds_byte(wc * 32 + fr, fq * 8);
#define PG8_SA(b, h) (((b) * 2 + (h)) * HTB)
#define PG8_SB(b, h) ((4 + (b) * 2 + (h)) * HTB)
#define PG8_STAGE(bufoff, gbase, voff) do { _Pragma("unroll") for (int _i = 0; _i < 2; ++_i) \
        __builtin_amdgcn_global_load_lds((const unsigned*)((const char*)(gbase) + (voff)[_i]), (PG8_LAS unsigned*)(lds + (bufoff) + ldsw + _i * 8192), 16, 0, 0); } while (0)
#define PG8_LDA(dst, b, h) do { _Pragma("unroll") for (int m = 0; m < 4; ++m) _Pragma("unroll") for (int k = 0; k < 2; ++k) dst[m][k] = *(const PG8_LAS bf16x8*)(lds + PG8_SA(b, h) + aoff + m * 2048 + k * 1024); } while (0)
#define PG8_LDB(dst, b, h) do { _Pragma("unroll") for (int n = 0; n < 2; ++n) _Pragma("unroll") for (int k = 0; k < 2; ++k) dst[n][k] = *(const PG8_LAS bf16x8*)(lds + PG8_SB(b, h) + boff + n * 2048 + k * 1024); } while (0)
#define PG8_MMA(ai, bj, At, Bt) do { __builtin_amdgcn_s_setprio(1); _Pragma("unroll") for (int m = 0; m < 4; ++m) _Pragma("unroll") for (int n = 0; n < 2; ++n) _Pragma("unroll") for (int k = 0; k < 2; ++k) \
        acc[ai][bj][m][n] = __builtin_amdgcn_mfma_f32_16x16x32_bf16(Bt[n][k], At[m][k], acc[ai][bj][m][n], 0, 0, 0); __builtin_amdgcn_s_setprio(0); } while (0)
#define PG8_WAIT_V(n) asm volatile("s_waitcnt vmcnt(" #n ")" ::: "memory")
#define PG8_WAIT_L(n) asm volatile("s_waitcnt lgkmcnt(" #n ")" ::: "memory")
#define PG8_BAR __builtin_amdgcn_s_barrier()
#define PG8_SCHED __builtin_amdgcn_sched_barrier(0)
    Unit cur, nxt; int ui = 0;
    if (!S.next(0, cur)) return;
    f32x4 acc[2][2][4][2];
#pragma unroll
    for (int a = 0; a < 2; ++a)
#pragma unroll
        for (int b = 0; b < 2; ++b)
#pragma unroll
            for (int m = 0; m < 4; ++m)
#pragma unroll
                for (int n = 0; n < 2; ++n) acc[a][b][m][n] = (f32x4){0.f, 0.f, 0.f, 0.f};
    if constexpr (Epi::HAS_INIT) E.init(acc, cur, wr, wc, fr, fq);
    bf16x8 At[4][2], B0[2][2], B1[2][2];
    const char* cA = (const char*)g.A + (size_t)cur.pm * tstepA; const char* cB = (const char*)g.Bt + (size_t)cur.pn * tstep;
    S.a_ready(cur);
    PG8_STAGE(PG8_SB(0, 0), cB, voffB); PG8_STAGE(PG8_SA(0, 0), cA, voffA); PG8_STAGE(PG8_SB(0, 1), cB + hstep, voffB); PG8_STAGE(PG8_SA(0, 1), cA + hstep, voffA);
    if (wr == 1) PG8_BAR;
    PG8_WAIT_V(4); PG8_BAR;
    PG8_STAGE(PG8_SB(1, 0), cB + kstep, voffB); PG8_STAGE(PG8_SA(1, 0), cA + kstep, voffA); PG8_STAGE(PG8_SB(1, 1), cB + hstep + kstep, voffB);
    PG8_WAIT_V(6); PG8_BAR;
    PG8_STAMP();
    for (;;) {
        const bool has_next = S.next(ui + 1, nxt);
        const char* nA = has_next ? (const char*)g.A + (size_t)nxt.pm * tstepA : cA; const char* nB = has_next ? (const char*)g.Bt + (size_t)nxt.pn * tstep : cB;
        for (int t = 0; t < nt; t += 2) {
            const bool last = (t == nt - 2);
            const char* a1 = cA + (size_t)(t + 1) * kstep;
            const char* a2 = last ? nA : cA + (size_t)(t + 2) * kstep; const char* b2 = last ? nB : cB + (size_t)(t + 2) * kstep;
            const char* a3 = a2 + kstep; const char* b3 = b2 + kstep;
            if (last && has_next) S.a_ready(nxt);
            PG8_LDB(B0, 0, 0); PG8_SCHED; PG8_LDA(At, 0, 0); PG8_STAGE(PG8_SA(1, 1), a1 + hstep, voffA);
            PG8_WAIT_L(8); PG8_BAR; PG8_WAIT_L(0); PG8_MMA(0, 0, At, B0); PG8_BAR; PG8_SCHED;
            PG8_LDB(B1, 0, 1); PG8_STAGE(PG8_SB(0, 0), b2, voffB);
            PG8_BAR; PG8_WAIT_L(0); PG8_MMA(0, 1, At, B1); PG8_BAR;
            PG8_LDA(At, 0, 1); PG8_STAGE(PG8_SA(0, 0), a2, voffA);
            PG8_BAR; PG8_WAIT_L(0); PG8_MMA(1, 0, At, B0); PG8_BAR; PG8_SCHED;
            PG8_STAGE(PG8_SB(0, 1), b2 + hstep, voffB);
            PG8_WAIT_V(6); PG8_BAR; PG8_MMA(1, 1, At, B1); PG8_BAR;
            PG8_LDB(B0, 1, 0); PG8_SCHED; PG8_LDA(At, 1, 0); PG8_STAGE(PG8_SA(0, 1), a2 + hstep, voffA);
            PG8_WAIT_L(8); PG8_BAR; PG8_WAIT_L(0); PG8_MMA(0, 0, At, B0); PG8_BAR; PG8_SCHED;
            PG8_LDB(B1, 1, 1); PG8_STAGE(PG8_SB(1, 0), b3, voffB);
            PG8_BAR; PG8_WAIT_L(0); PG8_MMA(0, 1, At, B1); PG8_BAR;
            PG8_LDA(At, 1, 1); PG8_STAGE(PG8_SA(1, 0), a3, voffA);
            PG8_BAR; PG8_WAIT_L(0); PG8_MMA(1, 0, At, B0); PG8_BAR; PG8_SCHED;
            PG8_STAGE(PG8_SB(1, 1), b3 + hstep, voffB);
            PG8_WAIT_V(6); PG8_BAR; PG8_MMA(1, 1, At, B1); PG8_BAR;
        }
        PG8_STAMP();
        if constexpr (!Epi::AFTER_DRAIN) { E(acc, cur, wr, wc, fr, fq); S.done(cur); }
        PG8_STAMP();
        if (!has_next) break;
#pragma unroll
        for (int a = 0; a < 2; ++a)
#pragma unroll
            for (int b = 0; b < 2; ++b)
#pragma unroll
                for (int m = 0; m < 4; ++m)
#pragma unroll
                    for (int n = 0; n < 2; ++n) acc[a][b][m][n] = (f32x4){0.f, 0.f, 0.f, 0.f};
        cur = nxt; cA = nA; cB = nB; ++ui;
    }
    PG8_WAIT_V(0);
    if (wr == 0) PG8_BAR;
    PG8_BAR;
    if constexpr (Epi::AFTER_DRAIN) { E.fused(acc, cur, wr, wc, fr, fq, lds, wid, lane); S.done(cur); }
    PG8_STAMP();
    if (STAMP && wid == 0) { stamps[lane] = lane < nts ? (((unsigned long long)(unsigned)ts_hi << 32) | (unsigned)ts_lo) : 0ull;
        if (lane == 62) stamps[62] = rt_entry; if (lane == 63) stamps[63] = (unsigned long long)wall_clock64(); }
#undef PG8_STAMP
#undef PG8_SA
#undef PG8_SB
#undef PG8_STAGE
#undef PG8_LDA
#undef PG8_LDB
#undef PG8_MMA
#undef PG8_WAIT_V
#undef PG8_WAIT_L
#undef PG8_BAR
#undef PG8_SCHED
}
}

typedef pg8::bf16_t bf16_t;
typedef pg8::f32x4 f32x4;
constexpr int SEQ = 16384, DM = 1024, NP = 7936, LW = 1344, LWP = 1408, DFF = 3072;
constexpr size_t MiB = (size_t)1 << 20;
constexpr size_t WS_WUP = 0, WS_WDOWN = 12 * MiB, WS_WOUT = 18 * MiB, WS_GLAWO = 20 * MiB, WS_LRUWO = 22 * MiB, WS_MISC = 25 * MiB, WS_WIN = 26 * MiB;
constexpr size_t WS_Q = 42 * MiB, WS_K = 58 * MiB, WS_V = 74 * MiB, WS_G = 106 * MiB, WS_XL = 138 * MiB, WS_GG = 180 * MiB, WS_SA = 222 * MiB, WS_FLOW = 254 * MiB, WS_ROWSQ = 255 * MiB;
constexpr size_t WS_HB = WS_Q;
constexpr size_t WS_MERGED = WS_XL;
constexpr size_t WS_X1B = 20 * MiB;
constexpr size_t WS_U = 52 * MiB;
constexpr size_t WS_HSAVE = 148 * MiB;
constexpr size_t WS_ACT = 56 * MiB;
constexpr size_t OUT_H1 = 0, OUT_SB = 32 * MiB, OUT_YAS = 0;
constexpr int LDS_BYTES = 160 * 1024;

#ifndef STAG
#define STAG 0
#endif
struct Params { const float* in[22]; float* out; unsigned char* ws; };

__device__ __forceinline__ float bf2f(bf16_t b) { return __uint_as_float(((unsigned)b) << 16); }
__device__ __forceinline__ void st4(bf16_t* p, f32x4 a) { uint2 w; w.x = pg8::cvt_pk_bf16(a[0], a[1]); w.y = pg8::cvt_pk_bf16(a[2], a[3]); *(uint2*)p = w; }
__device__ __forceinline__ f32x4 ld4(const bf16_t* p) { const uint2 w = *(const uint2*)p; f32x4 r; r[0] = __uint_as_float(w.x << 16); r[1] = __uint_as_float(w.x & 0xffff0000u); r[2] = __uint_as_float(w.y << 16); r[3] = __uint_as_float(w.y & 0xffff0000u); return r; }
__device__ __forceinline__ float sigm(float x) { return __builtin_amdgcn_rcpf(1.f + __builtin_amdgcn_exp2f(-1.4426950408889634f * x)); }
__device__ __forceinline__ float gelu_t(float x) { const float y = x * (-2.302208198f + -0.10294324f * x * x); return x * __builtin_amdgcn_rcpf(1.f + __builtin_amdgcn_exp2f(y)); }
__device__ __forceinline__ float wave_sum(float s) {
#pragma unroll
    for (int o = 32; o >= 1; o >>= 1) s += __shfl_xor(s, o);
    return s;
}

__device__ void rmsnorm_rows_bf16(const float* x, const float* g, bf16_t* out) {
    const int wave = threadIdx.x >> 6, lane = threadIdx.x & 63;
    for (int row = blockIdx.x * 8 + wave; row < SEQ; row += gridDim.x * 8) {
        const float* xr = x + (size_t)row * DM; f32x4 v[4]; float ss = 0.f;
#pragma unroll
        for (int i = 0; i < 2; ++i) { v[2 * i] = *(const f32x4*)(xr + i * 512 + lane * 8); v[2 * i + 1] = *(const f32x4*)(xr + i * 512 + lane * 8 + 4); }
#pragma unroll
        for (int i = 0; i < 4; ++i) ss += v[i][0] * v[i][0] + v[i][1] * v[i][1] + v[i][2] * v[i][2] + v[i][3] * v[i][3];
        ss = wave_sum(ss);
        const float r = rsqrtf(ss * (1.0f / DM) + 1e-6f);
#pragma unroll
        for (int i = 0; i < 2; ++i) { const f32x4 g0 = *(const f32x4*)(g + i * 512 + lane * 8), g1 = *(const f32x4*)(g + i * 512 + lane * 8 + 4);
            const f32x4 a = v[2 * i] * r * g0, c = v[2 * i + 1] * r * g1; uint4 w; w.x = pg8::cvt_pk_bf16(a[0], a[1]); w.y = pg8::cvt_pk_bf16(a[2], a[3]); w.z = pg8::cvt_pk_bf16(c[0], c[1]); w.w = pg8::cvt_pk_bf16(c[2], c[3]);
            *(uint4*)(out + (size_t)row * DM + i * 512 + lane * 8) = w; }
    }
}
__device__ void rmsnorm_rows_inplace(float* x, const float* g) {
    const int wave = threadIdx.x >> 6, lane = threadIdx.x & 63;
    for (int row = blockIdx.x * 8 + wave; row < SEQ; row += gridDim.x * 8) {
        float* xr = x + (size_t)row * DM; f32x4 v[4]; float ss = 0.f;
#pragma unroll
        for (int i = 0; i < 4; ++i) { v[i] = *(const f32x4*)(xr + i * 256 + lane * 4); ss += v[i][0] * v[i][0] + v[i][1] * v[i][1] + v[i][2] * v[i][2] + v[i][3] * v[i][3]; }
        ss = wave_sum(ss);
        const float r = rsqrtf(ss * (1.0f / DM) + 1e-6f);
#pragma unroll
        for (int i = 0; i < 4; ++i) { const f32x4 gv = *(const f32x4*)(g + i * 256 + lane * 4); *(f32x4*)(xr + i * 256 + lane * 4) = v[i] * r * gv; }
    }
}
__device__ __forceinline__ int colmap_win(int n) {
    if (n < 3072) return n;
    if (n < 4096) return 5776 + (n - 3072);
    if (n < 5120) return 6800 + (n - 4096);
    if (n < 6464) return 3088 + (n - 5120);
    if (n < 7808) return 4432 + (n - 6464);
    if (n < 7824) return 3072 + (n - 7808);
    return -1;
}
__device__ __forceinline__ int colmap_wup(int n) { return ((n >> 7) & 1 ? DFF : 0) + 128 * (n >> 8) + (n & 127); }
constexpr size_t WS_GATEW0 = 24 * MiB + 768 * 1024;
constexpr int NTILES_ALL = 1984 + 1536 + 768 + 352 + 256 + 256 + 144;
struct TDesc { const float* src; const float* rs; bf16_t* dst; int srcK, srcLd, srcNv, dstK, tk, mode, lt; };
__device__ __forceinline__ TDesc get_desc(const Params& P, int t) {
    unsigned char* ws = P.ws; TDesc d;
    if (t < 1984) { d = TDesc{P.in[2], nullptr, (bf16_t*)(ws + WS_WIN), 1024, 7824, 7824, 1024, 16, 1, t}; }
    else if (t < 3520) { d = TDesc{P.in[17], P.in[16], (bf16_t*)(ws + WS_WUP), 1024, 6144, 6144, 1024, 16, 2, t - 1984}; }
    else if (t < 4288) { d = TDesc{P.in[20], nullptr, (bf16_t*)(ws + WS_WDOWN), 3072, 1024, 1024, 3072, 48, 0, t - 3520}; }
    else if (t < 4640) { d = TDesc{P.in[14], nullptr, (bf16_t*)(ws + WS_LRUWO), 1344, 1024, 1024, 1408, 22, 0, t - 4288}; }
    else if (t < 4896) { d = TDesc{P.in[6], nullptr, (bf16_t*)(ws + WS_GLAWO), 1024, 1024, 1024, 1024, 16, 0, t - 4640}; }
    else if (t < 5152) { d = TDesc{P.in[15], nullptr, (bf16_t*)(ws + WS_WOUT), 1024, 1024, 1024, 1024, 16, 0, t - 4896}; }
    else { const int u = t - 5152, gsel = u / 9; d = TDesc{(gsel & 1 ? P.in[11] : P.in[9]) + (size_t)(gsel >> 1) * 168 * 168, nullptr, (bf16_t*)(ws + WS_GATEW0) + (size_t)gsel * 192 * 192, 168, 168, 168, 192, 3, 0, u - gsel * 9}; }
    return d;
}
template <int lo, int hi> __device__ void transpose_range(const Params& P, float* tile, int rank, int nranks) {
    const int lane = threadIdx.x & 63, i8 = threadIdx.x >> 6, nl = threadIdx.x >> 3, kg = threadIdx.x & 7;
    for (int base = lo + rank * 2; base < hi; base += nranks * 2) {
        float val[2][8];
#pragma unroll
        for (int u = 0; u < 2; ++u) {
            const int t = base + u;
            if (t < hi) {
                __builtin_assume(t >= lo && t < hi);
                const TDesc d = get_desc(P, t); const int k0 = (d.lt % d.tk) * 64, n0 = (d.lt / d.tk) * 64, n = n0 + (lane & 15) * 4;
                const int sc = d.mode == 1 ? colmap_win(n) : (d.mode == 2 ? colmap_wup(n) : (n < d.srcNv ? n : -1));
#pragma unroll
                for (int j = 0; j < 2; ++j) { const int k = k0 + i8 * 8 + j * 4 + (lane >> 4); f32x4 x = {0.f, 0.f, 0.f, 0.f};
                    if (sc >= 0 && k < d.srcK) { x = *(const f32x4*)(d.src + (size_t)k * d.srcLd + sc); if (d.rs) x = x * d.rs[k]; }
                    val[u][4 * j] = x[0]; val[u][4 * j + 1] = x[1]; val[u][4 * j + 2] = x[2]; val[u][4 * j + 3] = x[3]; }
            }
        }
#pragma unroll
        for (int u = 0; u < 2; ++u)
#pragma unroll
            for (int j = 0; j < 8; ++j) tile[u * 4160 + (i8 * 8 + (j >> 2) * 4 + (lane >> 4)) * 65 + (lane & 15) * 4 + (j & 3)] = val[u][j];
        __syncthreads();
#pragma unroll
        for (int u = 0; u < 2; ++u) {
            const int t = base + u;
            if (t < hi) {
                __builtin_assume(t >= lo && t < hi);
                const TDesc d = get_desc(P, t); const int k0 = (d.lt % d.tk) * 64, n0 = (d.lt / d.tk) * 64;
                float f[8];
#pragma unroll
                for (int j = 0; j < 8; ++j) f[j] = tile[u * 4160 + (kg * 8 + j) * 65 + nl];
                uint4 w; w.x = pg8::cvt_pk_bf16(f[0], f[1]); w.y = pg8::cvt_pk_bf16(f[2], f[3]); w.z = pg8::cvt_pk_bf16(f[4], f[5]); w.w = pg8::cvt_pk_bf16(f[6], f[7]);
                *(uint4*)(d.dst + (size_t)(n0 + nl) * d.dstK + k0 + kg * 8) = w;
            }
        }
        __syncthreads();
    }
}
template <int lo, int hi> __device__ __forceinline__ void transpose_in_idle_slot(const Params& P, float* tile, int n_units) {
    const int G = (int)gridDim.x, r = n_units % G;
    const int rank = r == 0 ? (int)blockIdx.x : (int)blockIdx.x - r, nranks = r == 0 ? G : G - r;
    if (rank >= 0) transpose_range<lo, hi>(P, tile, rank, nranks);
}

typedef unsigned u32x4n __attribute__((ext_vector_type(4)));
#ifndef NT_STORE
#define NT_STORE 0
#endif
__device__ __forceinline__ void st8(bf16_t* p, f32x4 a, f32x4 b) { u32x4n w; w[0] = pg8::cvt_pk_bf16(a[0], a[1]); w[1] = pg8::cvt_pk_bf16(a[2], a[3]); w[2] = pg8::cvt_pk_bf16(b[0], b[1]); w[3] = pg8::cvt_pk_bf16(b[2], b[3]);
    if (NT_STORE) __builtin_nontemporal_store(w, (u32x4n*)p); else *(u32x4n*)p = w; }
__device__ __forceinline__ void ld8(const bf16_t* p, f32x4& a, f32x4& b) { const uint4 w = *(const uint4*)p; a[0] = __uint_as_float(w.x << 16); a[1] = __uint_as_float(w.x & 0xffff0000u); a[2] = __uint_as_float(w.y << 16); a[3] = __uint_as_float(w.y & 0xffff0000u);
    b[0] = __uint_as_float(w.z << 16); b[1] = __uint_as_float(w.z & 0xffff0000u); b[2] = __uint_as_float(w.w << 16); b[3] = __uint_as_float(w.w & 0xffff0000u); }
template <class F> struct EpiGen {
    static constexpr bool PERM = true, AFTER_DRAIN = false, APERM = false, HAS_INIT = false; F f;
    __device__ __forceinline__ void operator()(f32x4 (&acc)[2][2][4][2], const pg8::Unit& u, int wr, int wc, int fr, int fq) const {
#pragma unroll
        for (int ai = 0; ai < 2; ++ai)
#pragma unroll
            for (int m = 0; m < 4; ++m) { const int row = u.pm * 256 + ai * 128 + wr * 64 + m * 16 + fr;
#pragma unroll
                for (int bj = 0; bj < 2; ++bj) f(row, u.pn * 256 + bj * 128 + wc * 32 + 8 * fq, acc[ai][bj][m][0], acc[ai][bj][m][1], u.pn * 256 + bj * 128 + wc * 32); }
    }
};
__device__ __forceinline__ f32x4 sigm4(f32x4 a) { f32x4 s; s[0] = sigm(a[0]); s[1] = sigm(a[1]); s[2] = sigm(a[2]); s[3] = sigm(a[3]); return s; }
__device__ __forceinline__ f32x4 gelu4(f32x4 a) { f32x4 s; s[0] = gelu_t(a[0]); s[1] = gelu_t(a[1]); s[2] = gelu_t(a[2]); s[3] = gelu_t(a[3]); return s; }
struct F1 {
    bf16_t *q, *k, *v, *g, *sA, *sB, *xl, *gg; float* flow;
    __device__ __forceinline__ void operator()(int row, int col, f32x4 a, f32x4 b, int cu) const {
        if (cu < 3072) {
            bf16_t* base; int ld, c;
            if (cu < 512) { base = q; ld = 512; c = col; } else if (cu < 1024) { base = k; ld = 512; c = col - 512; } else if (cu < 2048) { base = v; ld = 1024; c = col - 1024; } else { base = g; ld = 1024; c = col - 2048; }
            st8(base + (size_t)row * ld + c, a, b);
        } else if (cu < 5120) {
            if (cu < 4096) st8(sA + (size_t)row * DM + (col - 3072), sigm4(a), sigm4(b)); else st8(sB + (size_t)row * DM + (col - 4096), sigm4(a), sigm4(b));
        } else if (cu < 6464) { st8(xl + (size_t)row * LW + (col - 5120), a, b);
        } else if (cu < 7808) { st8(gg + (size_t)row * LW + (col - 6464), gelu4(a), gelu4(b));
        } else if (col < 7824) { float* p = flow + (size_t)row * 16 + (col - 7808); *(f32x4*)p = a; *(f32x4*)(p + 4) = b; }
    }
};
struct F2 {
    const bf16_t* sA; bf16_t* yas;
    __device__ __forceinline__ void operator()(int row, int col, f32x4 a, f32x4 b, int) const { const size_t o = (size_t)row * DM + col; f32x4 s0, s1; ld8(sA + o, s0, s1); st8(yas + o, s0 * a, s1 * b); }
};
struct F3 {
    const bf16_t *sB, *yas; bf16_t* merged;
    __device__ __forceinline__ void operator()(int row, int col, f32x4 a, f32x4 b, int) const { const size_t o = (size_t)row * DM + col; f32x4 s0, s1, y0, y1; ld8(sB + o, s0, s1); ld8(yas + o, y0, y1); st8(merged + o, y0 + s0 * a, y1 + s1 * b); }
};
constexpr int X1B_ROWS = 65 * 254 + 2;
struct E4 {
    static constexpr bool PERM = true, AFTER_DRAIN = false, APERM = false, HAS_INIT = true;
    const float* x; float* x1; bf16_t* x1b; float* rowsq;
    __device__ __forceinline__ void init(f32x4 (&acc)[2][2][4][2], const pg8::Unit& u, int wr, int wc, int fr, int fq) const {
#pragma unroll
        for (int ai = 0; ai < 2; ++ai)
#pragma unroll
            for (int m = 0; m < 4; ++m)
#pragma unroll
                for (int bj = 0; bj < 2; ++bj) { const float* p = x + (size_t)(u.pm * 256 + ai * 128 + wr * 64 + m * 16 + fr) * DM + u.pn * 256 + bj * 128 + wc * 32 + 8 * fq; acc[ai][bj][m][0] = *(const f32x4*)p; acc[ai][bj][m][1] = *(const f32x4*)(p + 4); }
    }
    __device__ __forceinline__ void operator()(f32x4 (&acc)[2][2][4][2], const pg8::Unit& u, int wr, int wc, int fr, int fq) const {
#pragma unroll
        for (int ai = 0; ai < 2; ++ai)
#pragma unroll
            for (int m = 0; m < 4; ++m) { const int row = u.pm * 256 + ai * 128 + wr * 64 + m * 16 + fr; float ss = 0.f;
#pragma unroll
                for (int bj = 0; bj < 2; ++bj) { const size_t o = (size_t)row * DM + u.pn * 256 + bj * 128 + wc * 32 + 8 * fq;
                    const f32x4 r0 = acc[ai][bj][m][0], r1 = acc[ai][bj][m][1];
                    st8(x1b + o + 2 * DM, r0, r1);
                    ss += r0[0] * r0[0] + r0[1] * r0[1] + r0[2] * r0[2] + r0[3] * r0[3] + r1[0] * r1[0] + r1[1] * r1[1] + r1[2] * r1[2] + r1[3] * r1[3]; }
                ss += __shfl_xor(ss, 16); ss += __shfl_xor(ss, 32);
                if (fq == 0) atomicAdd(rowsq + row, ss); }
    }
};
struct E6 {
    static constexpr bool PERM = true, AFTER_DRAIN = false, APERM = false, HAS_INIT = true;
    float* xo; const bf16_t* x1b;
    __device__ __forceinline__ void init(f32x4 (&acc)[2][2][4][2], const pg8::Unit& u, int wr, int wc, int fr, int fq) const {
#pragma unroll
        for (int ai = 0; ai < 2; ++ai)
#pragma unroll
            for (int m = 0; m < 4; ++m)
#pragma unroll
                for (int bj = 0; bj < 2; ++bj) { const bf16_t* p = x1b + (size_t)(2 + u.pm * 256 + ai * 128 + wr * 64 + m * 16 + fr) * DM + u.pn * 256 + bj * 128 + wc * 32 + 8 * fq; ld8(p, acc[ai][bj][m][0], acc[ai][bj][m][1]); }
    }
    __device__ __forceinline__ void operator()(f32x4 (&acc)[2][2][4][2], const pg8::Unit& u, int wr, int wc, int fr, int fq) const {
#pragma unroll
        for (int ai = 0; ai < 2; ++ai)
#pragma unroll
            for (int m = 0; m < 4; ++m)
#pragma unroll
                for (int bj = 0; bj < 2; ++bj) { float* p = xo + (size_t)(u.pm * 256 + ai * 128 + wr * 64 + m * 16 + fr) * DM + u.pn * 256 + bj * 128 + wc * 32 + 8 * fq; *(f32x4*)p = acc[ai][bj][m][0]; *(f32x4*)(p + 4) = acc[ai][bj][m][1]; }
    }
};
constexpr int XCH_OFF = 131072;
struct E5f {
    static constexpr bool PERM = true, AFTER_DRAIN = false, APERM = true, HAS_INIT = false;
    const float* rowsq; const float* cw; const float* cb; bf16_t* act; PG8_LAS float* X;
    __device__ __forceinline__ static f32x4 rot(f32x4 v, int) { f32x4 r;
#pragma unroll
        for (int j = 0; j < 4; ++j) r[j] = __int_as_float(__builtin_amdgcn_update_dpp(0, __float_as_int(v[j]), 0x111, 0xf, 0xf, false));
        return r; }
    __device__ __forceinline__ void operator()(f32x4 (&acc)[2][2][4][2], const pg8::Unit& u, int wr, int wc, int fr_, int fq_) const {
        int fr = fr_, fq = fq_; asm volatile("" : "+v"(fr), "+v"(fq));
        const int lane = fq * 16 + fr;
#pragma unroll
        for (int ai = 0; ai < 2; ++ai)
#pragma unroll
            for (int m = 0; m < 4; ++m) { int gr = 254 * u.pm + ai * 128 + wr * 64 + 4 * fr + m - 2; gr = gr < 0 ? 0 : (gr > SEQ - 1 ? SEQ - 1 : gr);
                const float r = rsqrtf(rowsq[gr] * (1.0f / DM) + 1e-6f);
#pragma unroll
                for (int bj = 0; bj < 2; ++bj) { acc[ai][bj][m][0] = acc[ai][bj][m][0] * r; acc[ai][bj][m][1] = acc[ai][bj][m][1] * r; }
                asm volatile("" : "+v"(acc[ai][0][m][0]), "+v"(acc[ai][0][m][1]), "+v"(acc[ai][1][m][0]), "+v"(acc[ai][1][m][1])); }
#pragma unroll
        for (int ai = 0; ai < 2; ++ai) { const int slot = 2 * ai + wr;
            if (slot < 3 && fr == 15) {
#pragma unroll
                for (int bj = 0; bj < 2; ++bj)
#pragma unroll
                    for (int rs = 0; rs < 2; ++rs) { PG8_LAS float* xp = X + ((((slot * 2 + rs) * 2 + bj) * 4 + wc) * 4 + fq) * 8; *(PG8_LAS f32x4*)xp = acc[ai][bj][2 + rs][0]; *(PG8_LAS f32x4*)(xp + 4) = acc[ai][bj][2 + rs][1]; } } }
        asm volatile("s_waitcnt lgkmcnt(0)" ::: "memory"); __builtin_amdgcn_s_barrier(); asm volatile("" ::: "memory");
        __builtin_amdgcn_s_barrier(); asm volatile("" ::: "memory");
        const int ch0 = 128 * u.pn + 32 * wc + 8 * fq; const int s1 = (lane & 48) | ((fr - 1) & 15); const bool f0 = fr == 0;
#pragma unroll
        for (int bj = 0; bj < 2; ++bj) {
#pragma unroll
            for (int n = 0; n < 2; ++n) {
                const float* wp = cw + bj * DFF + ch0 + 4 * n;
                const f32x4 w0 = *(const f32x4*)wp, w1 = *(const f32x4*)(wp + 2 * DFF), w2 = *(const f32x4*)(wp + 4 * DFF), bb = *(const f32x4*)(cb + bj * DFF + ch0 + 4 * n);
#pragma unroll
                for (int ai = 0; ai < 2; ++ai) {
                    const int slot = 2 * ai + wr - 1; f32x4 bm1 = {0.f, 0.f, 0.f, 0.f}, bm2 = {0.f, 0.f, 0.f, 0.f};
                    if (slot >= 0) { bm2 = *(const PG8_LAS f32x4*)(X + ((((slot * 2 + 0) * 2 + bj) * 4 + wc) * 4 + fq) * 8 + 4 * n); bm1 = *(const PG8_LAS f32x4*)(X + ((((slot * 2 + 1) * 2 + bj) * 4 + wc) * 4 + fq) * 8 + 4 * n); }
                    const f32x4 x0 = acc[ai][bj][0][n], x1v = acc[ai][bj][1][n], x2v = acc[ai][bj][2][n], x3v = acc[ai][bj][3][n];
                    const f32x4 r3 = rot(x3v, s1), r2 = rot(x2v, s1);
                    f32x4 o0, o1, o2, o3;
#pragma unroll
                    for (int j = 0; j < 4; ++j) {
                        const float p1 = f0 ? bm1[j] : r3[j], p2 = f0 ? bm2[j] : r2[j];
                        o0[j] = bb[j] + w2[j] * x0[j] + w1[j] * p1 + w0[j] * p2;
                        o1[j] = bb[j] + w2[j] * x1v[j] + w1[j] * x0[j] + w0[j] * p1;
                        o2[j] = bb[j] + w2[j] * x2v[j] + w1[j] * x1v[j] + w0[j] * x0[j];
                        o3[j] = bb[j] + w2[j] * x3v[j] + w1[j] * x2v[j] + w0[j] * x1v[j];
                    }
                    acc[ai][bj][0][n] = o0; acc[ai][bj][1][n] = o1; acc[ai][bj][2][n] = o2; acc[ai][bj][3][n] = o3;
                    asm volatile("" : "+v"(acc[ai][bj][0][n]), "+v"(acc[ai][bj][1][n]), "+v"(acc[ai][bj][2][n]), "+v"(acc[ai][bj][3][n]));
                    __builtin_amdgcn_sched_barrier(0);
                }
                asm volatile("" ::: "memory");
            }
        }
#pragma unroll
        for (int ai = 0; ai < 2; ++ai)
#pragma unroll
            for (int m = 0; m < 4; ++m) { const int lr = ai * 128 + wr * 64 + 4 * fr + m, gr = 254 * u.pm + lr - 2;
                if (lr >= 2 && gr < SEQ) st8(act + (size_t)gr * DFF + ch0, gelu4(acc[ai][0][m][0]) * acc[ai][1][m][0], gelu4(acc[ai][0][m][1]) * acc[ai][1][m][1]); }
    }
};
struct F6 {
    float* x1;
    __device__ __forceinline__ void operator()(int row, int col, f32x4 a, f32x4 b, int) const { float* p = x1 + (size_t)row * DM + col; *(f32x4*)p = *(const f32x4*)p + a; *(f32x4*)(p + 4) = *(const f32x4*)(p + 4) + b; }
};

#ifdef NAIVE_GLA
__device__ void gla_naive(const Params& P, float* sm) {
    if (blockIdx.x >= 4) return;
    const int h = blockIdx.x, tid = threadIdx.x;
    const bf16_t* q = (const bf16_t*)(P.ws + WS_Q); const bf16_t* k = (const bf16_t*)(P.ws + WS_K); const bf16_t* v = (const bf16_t*)(P.ws + WS_V); bf16_t* g = (bf16_t*)(P.ws + WS_G);
    const float* flow = (const float*)(P.ws + WS_FLOW); const float* wf2 = P.in[3]; const float* bf2 = P.in[4]; const float* onorm = P.in[5];
    float* al = sm; float* qs = sm + 128; float* ks = sm + 256; float* red = sm + 384;
    float St[128];
#pragma unroll
    for (int i = 0; i < 128; ++i) St[i] = 0.f;
    float wcol[16]; float bcol = 0.f;
    if (tid < 128) {
#pragma unroll
        for (int r = 0; r < 16; ++r) wcol[r] = wf2[r * 512 + h * 128 + tid];
        bcol = bf2[h * 128 + tid];
    } else {
#pragma unroll
        for (int r = 0; r < 16; ++r) wcol[r] = 0.f;
    }
    const float on = tid < 256 ? onorm[tid] : 0.f;
    for (int t = 0; t < SEQ; ++t) {
        if (tid < 128) {
            float z = bcol;
#pragma unroll
            for (int r = 0; r < 16; ++r) z += flow[(size_t)t * 16 + r] * wcol[r];
            const float ls = fminf(z, 0.f) - log1pf(__expf(-fabsf(z)));
            al[tid] = __expf(ls * (1.0f / 16.0f));
            qs[tid] = bf2f(q[(size_t)t * 512 + h * 128 + tid]) * 0.08838834764831845f;
            ks[tid] = bf2f(k[(size_t)t * 512 + h * 128 + tid]);
        }
        __syncthreads();
        float o = 0.f;
        if (tid < 256) {
            const float vv = bf2f(v[(size_t)t * 1024 + h * 256 + tid]);
#pragma unroll
            for (int i = 0; i < 128; ++i) { St[i] = al[i] * St[i] + ks[i] * vv; o += qs[i] * St[i]; }
        }
        const float s2 = wave_sum(o * o);
        if ((tid & 63) == 0) red[tid >> 6] = s2;
        __syncthreads();
        if (tid < 256) {
            const float tot = red[0] + red[1] + red[2] + red[3];
            const float rr = rsqrtf(tot * (1.0f / 256.0f) + 1e-6f);
            const size_t gi = (size_t)t * 1024 + h * 256 + tid;
            const float gv = bf2f(g[gi]);
            const float res = o * rr * on * (gv * sigm(gv));
            g[gi] = (bf16_t)(pg8::cvt_pk_bf16(res, 0.f) & 0xffffu);
        }
    }
}
#endif
#ifdef NAIVE_LRU
__device__ void lru_naive(const Params& P, float* sm) {
    if (blockIdx.x >= 8) return;
    const int j = blockIdx.x, tid = threadIdx.x; const bool act = tid < 168; const int ch = j * 168 + (act ? tid : 0);
    const bf16_t* xl = (const bf16_t*)(P.ws + WS_XL); const bf16_t* gg = (const bf16_t*)(P.ws + WS_GG); bf16_t* hb = (bf16_t*)(P.ws + WS_HB);
    const float* cw = P.in[7]; const float* cb = P.in[8]; const float* wa = P.in[9] + (size_t)j * 168 * 168; const float* ba = P.in[10]; const float* wx = P.in[11] + (size_t)j * 168 * 168; const float* bx = P.in[12]; const float* ap = P.in[13];
    const float w0 = cw[ch], w1 = cw[LW + ch], w2 = cw[2 * LW + ch], w3 = cw[3 * LW + ch], b0 = cb[ch], bav = ba[ch], bxv = bx[ch];
    const float apv = ap[ch]; const float sp = fmaxf(apv, 0.f) + log1pf(__expf(-fabsf(apv)));
    float x3 = 0.f, x2 = 0.f, x1 = 0.f, hs = 0.f;
    float* xcs = sm;
    for (int t = 0; t < SEQ; ++t) {
        float xc = 0.f;
        if (act) { const float xv = bf2f(xl[(size_t)t * LW + ch]); xc = b0 + w0 * x3 + w1 * x2 + w2 * x1 + w3 * xv; x3 = x2; x2 = x1; x1 = xv; xcs[tid] = xc; }
        __syncthreads();
        if (act) {
            float ra = bav, ri = bxv;
            for (int c = 0; c < 168; ++c) { const float xv = xcs[c]; ra += xv * wa[c * 168 + tid]; ri += xv * wx[c * 168 + tid]; }
            const float r = sigm(ra), ig = sigm(ri);
            const float la = -8.0f * r * sp; const float a = __expf(la);
            const float uu = sqrtf(-expm1f(2.0f * la)) * (ig * xc);
            hs = a * hs + uu;
            const float res = hs * bf2f(gg[(size_t)t * LW + ch]);
            hb[(size_t)t * LWP + ch] = (bf16_t)(pg8::cvt_pk_bf16(res, 0.f) & 0xffffu);
        } else if (tid < 176) { hb[(size_t)t * LWP + LW + j * 8 + (tid - 168)] = 0; }
        __syncthreads();
    }
}
#endif
typedef pg8::bf16x8 bf16x8;
typedef unsigned u32x4_t __attribute__((ext_vector_type(4)));
typedef unsigned u32x2_t __attribute__((ext_vector_type(2)));
#define LAS PG8_LAS
constexpr int GL_QS = 0, GL_KT = 17408, GL_KST = 34816, GL_VT = 53248, GL_AM = 90112, GL_DEC = 99328, GL_RSQ = 99840, GL_WF = 101888, GL_BF = 110080;
constexpr int RS128 = 272, RS64 = 144;
constexpr size_t WS_GATEW = 24 * MiB + 768 * 1024;
constexpr size_t WS_DSEG = 25 * MiB + 896 * 1024;
constexpr size_t OUT_L = 0;
constexpr size_t OUT_SUMS = 0;
constexpr size_t OUT_CARRY = 4 * MiB;

__device__ __forceinline__ unsigned short f2bf(float x) { return (unsigned short)(pg8::cvt_pk_bf16(x, 0.f) & 0xffffu); }
__device__ __forceinline__ bf16x8 pack8(f32x4 a, f32x4 b) { u32x4_t w; w[0] = pg8::cvt_pk_bf16(a[0], a[1]); w[1] = pg8::cvt_pk_bf16(a[2], a[3]); w[2] = pg8::cvt_pk_bf16(b[0], b[1]); w[3] = pg8::cvt_pk_bf16(b[2], b[3]); return __builtin_bit_cast(bf16x8, w); }
#define MFMA16(a, b, c) __builtin_amdgcn_mfma_f32_16x16x32_bf16((a), (b), (c), 0, 0, 0)

template <bool OUT>
__device__ void gla_pass(const Params& P, LAS unsigned char* lds) {
    const int tid = threadIdx.x, lane = tid & 63, w = __builtin_amdgcn_readfirstlane(tid >> 6), fr = lane & 15, fq = lane >> 4;
    const bf16_t* q = (const bf16_t*)(P.ws + WS_Q); const bf16_t* k = (const bf16_t*)(P.ws + WS_K); const bf16_t* v = (const bf16_t*)(P.ws + WS_V); bf16_t* g = (bf16_t*)(P.ws + WS_G);
    const float* flow = (const float*)(P.ws + WS_FLOW); const float* wf2 = P.in[3]; const float* bf2 = P.in[4]; const float* onorm = P.in[5];
    float* L = (float*)((unsigned char*)P.out + OUT_L); float* Dg = (float*)(P.ws + WS_DSEG);
    LAS float* dec = (LAS float*)(lds + GL_DEC); LAS float* rsq = (LAS float*)(lds + GL_RSQ);
    for (int item = blockIdx.x; item < 256; item += gridDim.x) {
        const int s = item >> 2, h = item & 3;
        f32x4 Sa[8][2];
        float* Lp = L + (size_t)(s * 4 + h) * 32768 + w * 4096;
#pragma unroll
        for (int mt = 0; mt < 8; ++mt)
#pragma unroll
            for (int ni = 0; ni < 2; ++ni) Sa[mt][ni] = OUT ? *(const f32x4*)(Lp + ((mt * 2 + ni) * 64 + lane) * 4) : (f32x4){0.f, 0.f, 0.f, 0.f};
        float blsum[16];
#pragma unroll
        for (int i = 0; i < 16; ++i) blsum[i] = 0.f;
        for (int e = tid; e < 2048; e += 512) { const int r = e >> 7, kc = e & 127; *(LAS float*)(lds + GL_WF + (kc * 16 + r) * 4) = wf2[r * 512 + h * 128 + kc]; }
        if (tid < 128) *(LAS float*)(lds + GL_BF + tid * 4) = bf2[h * 128 + tid];
        __syncthreads();
        f32x4 flp[4]; uint4 qap, qbp, kap, kbp;
        if constexpr (!OUT) { const size_t tp = (size_t)(s * 256 + lane);
#pragma unroll
          for (int r4 = 0; r4 < 4; ++r4) flp[r4] = *(const f32x4*)(flow + tp * 16 + r4 * 4);
          qap = *(const uint4*)(q + tp * 512 + h * 128 + 16 * w); qbp = *(const uint4*)(q + tp * 512 + h * 128 + 16 * w + 8);
          kap = *(const uint4*)(k + tp * 512 + h * 128 + 16 * w); kbp = *(const uint4*)(k + tp * 512 + h * 128 + 16 * w + 8); }
        for (int ch = 0; ch < 4; ++ch) {
            const int t0 = s * 256 + ch * 64; const size_t t = (size_t)(t0 + lane);
            uint4 vpre[4];
#pragma unroll
            for (int i = 0; i < 4; ++i) vpre[i] = *(const uint4*)(v + t * 1024 + h * 256 + 8 * (w + 8 * i));
            uint2 gpre[4][2];
            if (OUT) {
#pragma unroll
                for (int nt = 0; nt < 4; ++nt)
#pragma unroll
                    for (int mi = 0; mi < 2; ++mi) gpre[nt][mi] = *(const uint2*)(g + (size_t)(t0 + 16 * nt + fr) * 1024 + h * 256 + 16 * (2 * w + mi) + 4 * fq);
            }
            {
                float fl[16]; uint4 qa, qb, ka, kb;
                if constexpr (OUT) {
#pragma unroll
                    for (int r4 = 0; r4 < 4; ++r4) { const f32x4 x = *(const f32x4*)(flow + t * 16 + r4 * 4); fl[r4 * 4] = x[0]; fl[r4 * 4 + 1] = x[1]; fl[r4 * 4 + 2] = x[2]; fl[r4 * 4 + 3] = x[3]; }
                    qa = *(const uint4*)(q + t * 512 + h * 128 + 16 * w); qb = *(const uint4*)(q + t * 512 + h * 128 + 16 * w + 8);
                    ka = *(const uint4*)(k + t * 512 + h * 128 + 16 * w); kb = *(const uint4*)(k + t * 512 + h * 128 + 16 * w + 8);
                } else {
#pragma unroll
                    for (int r4 = 0; r4 < 4; ++r4) { const f32x4 x = flp[r4]; fl[r4 * 4] = x[0]; fl[r4 * 4 + 1] = x[1]; fl[r4 * 4 + 2] = x[2]; fl[r4 * 4 + 3] = x[3]; }
                    qa = qap; qb = qbp; ka = kap; kb = kbp;
                    if (ch < 3) { const size_t tn = t + 64;
#pragma unroll
                        for (int r4 = 0; r4 < 4; ++r4) flp[r4] = *(const f32x4*)(flow + tn * 16 + r4 * 4);
                        qap = *(const uint4*)(q + tn * 512 + h * 128 + 16 * w); qbp = *(const uint4*)(q + tn * 512 + h * 128 + 16 * w + 8);
                        kap = *(const uint4*)(k + tn * 512 + h * 128 + 16 * w); kbp = *(const uint4*)(k + tn * 512 + h * 128 + 16 * w + 8); }
                }
                const unsigned qw[8] = {qa.x, qa.y, qa.z, qa.w, qb.x, qb.y, qb.z, qb.w}, kw[8] = {ka.x, ka.y, ka.z, ka.w, kb.x, kb.y, kb.z, kb.w};
                float qt[16], kt[16];
#pragma unroll
                for (int i = 0; i < 16; ++i) {
                    float z = *(const LAS float*)(lds + GL_BF + (16 * w + i) * 4);
#pragma unroll
                    for (int r4 = 0; r4 < 4; ++r4) { const f32x4 wv = *(const LAS f32x4*)(lds + GL_WF + ((16 * w + i) * 16 + r4 * 4) * 4); z += fl[r4 * 4] * wv[0] + fl[r4 * 4 + 1] * wv[1] + fl[r4 * 4 + 2] * wv[2] + fl[r4 * 4 + 3] * wv[3]; }
                    float b = (fminf(z, 0.f) - __logf(1.0f + __expf(-fabsf(z)))) * (1.0f / 16.0f);
                    b += __int_as_float(__builtin_amdgcn_update_dpp(0, __float_as_int(b), 0x111, 0xf, 0xf, false));
                    b += __int_as_float(__builtin_amdgcn_update_dpp(0, __float_as_int(b), 0x112, 0xf, 0xf, false));
                    b += __int_as_float(__builtin_amdgcn_update_dpp(0, __float_as_int(b), 0x114, 0xf, 0xf, false));
                    b += __int_as_float(__builtin_amdgcn_update_dpp(0, __float_as_int(b), 0x118, 0xf, 0xf, false));
                    { const float t0r = __int_as_float(__builtin_amdgcn_readlane(__float_as_int(b), 15)), t1r = __int_as_float(__builtin_amdgcn_readlane(__float_as_int(b), 31)), t2r = __int_as_float(__builtin_amdgcn_readlane(__float_as_int(b), 47));
                      b += fq == 0 ? 0.f : (fq == 1 ? t0r : (fq == 2 ? t0r + t1r : t0r + t1r + t2r)); }
                    const float bl = __int_as_float(__builtin_amdgcn_readlane(__float_as_int(b), 63));
                    const float qv = (i & 1) ? __uint_as_float(qw[i >> 1] & 0xffff0000u) : __uint_as_float(qw[i >> 1] << 16);
                    const float kv = (i & 1) ? __uint_as_float(kw[i >> 1] & 0xffff0000u) : __uint_as_float(kw[i >> 1] << 16);
                    qt[i] = qv * __expf(b) * 0.08838834764831845f; kt[i] = kv * __expf(-b);
                    *(LAS unsigned short*)(lds + GL_KST + (16 * w + i) * RS64 + lane * 2) = f2bf(kv * __expf(bl - b));
                    if (lane == 63) dec[16 * w + i] = __expf(bl);
                    blsum[i] += bl;
                }
                u32x4_t p0, p1;
#pragma unroll
                for (int i = 0; i < 4; ++i) { p0[i] = pg8::cvt_pk_bf16(qt[2 * i], qt[2 * i + 1]); p1[i] = pg8::cvt_pk_bf16(qt[8 + 2 * i], qt[8 + 2 * i + 1]); }
                *(LAS u32x4_t*)(lds + GL_QS + lane * RS128 + 32 * w) = p0; *(LAS u32x4_t*)(lds + GL_QS + lane * RS128 + 32 * w + 16) = p1;
#pragma unroll
                for (int i = 0; i < 4; ++i) { p0[i] = pg8::cvt_pk_bf16(kt[2 * i], kt[2 * i + 1]); p1[i] = pg8::cvt_pk_bf16(kt[8 + 2 * i], kt[8 + 2 * i + 1]); }
                *(LAS u32x4_t*)(lds + GL_KT + lane * RS128 + 32 * w) = p0; *(LAS u32x4_t*)(lds + GL_KT + lane * RS128 + 32 * w + 16) = p1;
            }
#pragma unroll
            for (int i = 0; i < 4; ++i) {
                const int cgp = w + 8 * i; const uint4 vv = vpre[i]; const unsigned vw[4] = {vv.x, vv.y, vv.z, vv.w};
#pragma unroll
                for (int e = 0; e < 8; ++e) *(LAS unsigned short*)(lds + GL_VT + (8 * cgp + e) * RS64 + lane * 2) = (unsigned short)((e & 1) ? (vw[e >> 1] >> 16) : (vw[e >> 1] & 0xffffu));
            }
            __syncthreads();
            if (OUT) {
                {
                    const int nt = w & 3;
#pragma unroll
                    for (int mm = 0; mm < 2; ++mm) {
                        const int mt = 2 * (w >> 2) + mm; f32x4 acc = {0.f, 0.f, 0.f, 0.f};
                        if (mt <= nt) {
#pragma unroll
                            for (int kk = 0; kk < 4; ++kk) { const bf16x8 a = *(const LAS bf16x8*)(lds + GL_KT + (16 * mt + fr) * RS128 + (32 * kk + 8 * fq) * 2); const bf16x8 b = *(const LAS bf16x8*)(lds + GL_QS + (16 * nt + fr) * RS128 + (32 * kk + 8 * fq) * 2); acc = MFMA16(a, b, acc); }
                        }
#pragma unroll
                        for (int j = 0; j < 4; ++j) if (16 * mt + 4 * fq + j > 16 * nt + fr) acc[j] = 0.f;
                        u32x2_t pw; pw[0] = pg8::cvt_pk_bf16(acc[0], acc[1]); pw[1] = pg8::cvt_pk_bf16(acc[2], acc[3]);
                        *(LAS u32x2_t*)(lds + GL_AM + (16 * nt + fr) * RS64 + (16 * mt + 4 * fq) * 2) = pw;
                    }
                }
                __syncthreads();
                f32x4 oT[2][4];
#pragma unroll
                for (int mi = 0; mi < 2; ++mi)
#pragma unroll
                    for (int nt = 0; nt < 4; ++nt) oT[mi][nt] = (f32x4){0.f, 0.f, 0.f, 0.f};
#pragma unroll
                for (int kk = 0; kk < 2; ++kk) {
                    bf16x8 bfr[4];
#pragma unroll
                    for (int nt = 0; nt < 4; ++nt) bfr[nt] = *(const LAS bf16x8*)(lds + GL_AM + (16 * nt + fr) * RS64 + (32 * kk + 8 * fq) * 2);
#pragma unroll
                    for (int mi = 0; mi < 2; ++mi) { const bf16x8 a = *(const LAS bf16x8*)(lds + GL_VT + (16 * (2 * w + mi) + fr) * RS64 + (32 * kk + 8 * fq) * 2);
#pragma unroll
                        for (int nt = 0; nt < 4; ++nt) oT[mi][nt] = MFMA16(a, bfr[nt], oT[mi][nt]); }
                }
#pragma unroll
                for (int kk = 0; kk < 4; ++kk) {
                    bf16x8 bfr[4];
#pragma unroll
                    for (int nt = 0; nt < 4; ++nt) { const u32x2_t lo = *(const LAS u32x2_t*)(lds + GL_QS + (16 * nt + fr) * RS128 + (32 * kk + 4 * fq) * 2), hi = *(const LAS u32x2_t*)(lds + GL_QS + (16 * nt + fr) * RS128 + (32 * kk + 16 + 4 * fq) * 2);
                        u32x4_t wv; wv[0] = lo[0]; wv[1] = lo[1]; wv[2] = hi[0]; wv[3] = hi[1]; bfr[nt] = __builtin_bit_cast(bf16x8, wv); }
#pragma unroll
                    for (int mi = 0; mi < 2; ++mi) { const bf16x8 a = pack8(Sa[2 * kk][mi], Sa[2 * kk + 1][mi]);
#pragma unroll
                        for (int nt = 0; nt < 4; ++nt) oT[mi][nt] = MFMA16(a, bfr[nt], oT[mi][nt]); }
                }
#pragma unroll
                for (int nt = 0; nt < 4; ++nt) {
                    float ps = 0.f;
#pragma unroll
                    for (int mi = 0; mi < 2; ++mi)
#pragma unroll
                        for (int j = 0; j < 4; ++j) ps += oT[mi][nt][j] * oT[mi][nt][j];
                    ps += __shfl_xor(ps, 16); ps += __shfl_xor(ps, 32);
                    if (fq == 0) rsq[(16 * nt + fr) * 8 + w] = ps;
                }
                __syncthreads();
#pragma unroll
                for (int nt = 0; nt < 4; ++nt) {
                    const f32x4 r0 = *(const LAS f32x4*)(rsq + (16 * nt + fr) * 8), r1 = *(const LAS f32x4*)(rsq + (16 * nt + fr) * 8 + 4);
                    const float tot = (r0[0] + r0[1]) + (r0[2] + r0[3]) + (r1[0] + r1[1]) + (r1[2] + r1[3]);
                    const float rstd = rsqrtf(tot * (1.0f / 256.0f) + 1e-6f);
#pragma unroll
                    for (int mi = 0; mi < 2; ++mi) {
                        const int c = 16 * (2 * w + mi) + 4 * fq; const size_t gi = (size_t)(t0 + 16 * nt + fr) * 1024 + h * 256 + c;
                        f32x4 gv; { const uint2 gw2 = gpre[nt][mi]; gv[0] = __uint_as_float(gw2.x << 16); gv[1] = __uint_as_float(gw2.x & 0xffff0000u); gv[2] = __uint_as_float(gw2.y << 16); gv[3] = __uint_as_float(gw2.y & 0xffff0000u); }
                        const f32x4 on = *(const f32x4*)(onorm + c); f32x4 res;
#pragma unroll
                        for (int j = 0; j < 4; ++j) res[j] = oT[mi][nt][j] * rstd * on[j] * (gv[j] * sigm(gv[j]));
                        st4(g + gi, res);
                    }
                }
            }
#pragma unroll
            for (int mt = 0; mt < 8; ++mt) { const f32x4 dv = *(const LAS f32x4*)(dec + 16 * mt + 4 * fq);
#pragma unroll
                for (int ni = 0; ni < 2; ++ni) Sa[mt][ni] = Sa[mt][ni] * dv; }
#pragma unroll
            for (int kk = 0; kk < 2; ++kk) {
                bf16x8 bfr[2];
#pragma unroll
                for (int ni = 0; ni < 2; ++ni) bfr[ni] = *(const LAS bf16x8*)(lds + GL_VT + (16 * (2 * w + ni) + fr) * RS64 + (32 * kk + 8 * fq) * 2);
#pragma unroll
                for (int mt = 0; mt < 8; ++mt) { const bf16x8 a = *(const LAS bf16x8*)(lds + GL_KST + (16 * mt + fr) * RS64 + (32 * kk + 8 * fq) * 2);
#pragma unroll
                    for (int ni = 0; ni < 2; ++ni) Sa[mt][ni] = MFMA16(a, bfr[ni], Sa[mt][ni]); }
            }
            __syncthreads();
        }
        if (!OUT) {
#pragma unroll
            for (int mt = 0; mt < 8; ++mt)
#pragma unroll
                for (int ni = 0; ni < 2; ++ni) *(f32x4*)(Lp + ((mt * 2 + ni) * 64 + lane) * 4) = Sa[mt][ni];
            if (lane == 0) {
#pragma unroll
                for (int i = 0; i < 16; ++i) Dg[(s * 4 + h) * 128 + 16 * w + i] = __expf(blsum[i]);
            }
        }
    }
}
__device__ void gla_scan(const Params& P) {
    float* L = (float*)((unsigned char*)P.out + OUT_L); const float* Dg = (const float*)(P.ws + WS_DSEG);
    for (int e = blockIdx.x * 512 + threadIdx.x; e < 131072; e += gridDim.x * 512) {
        const int h = e >> 15, r = e & 32767, mt = (r >> 9) & 7, ln = (r >> 2) & 63, j = r & 3; const int kk = 16 * mt + 4 * (ln >> 4) + j;
        float st = 0.f;
        for (int s0 = 0; s0 < 64; s0 += 32) {
            float tmp[32], dd[32];
#pragma unroll
            for (int i = 0; i < 32; ++i) { tmp[i] = L[(size_t)((s0 + i) * 4 + h) * 32768 + r]; dd[i] = Dg[((s0 + i) * 4 + h) * 128 + kk]; }
#pragma unroll
            for (int i = 0; i < 32; ++i) { L[(size_t)((s0 + i) * 4 + h) * 32768 + r] = st; st = dd[i] * st + tmp[i]; }
        }
    }
}

constexpr int LR_XCB = 0, LR_XCF = 25600, LR_AA = 71680, LR_PE = 117760, LR_CW = 121792, LR_XN = 127488;
constexpr int XCB_RS = 400, XCF_RS = 720;
constexpr size_t WS_SP = 255 * MiB + 64 * 1024;
__device__ void lru_pass1(const Params& P, LAS unsigned char* lds) {
    const int tid = threadIdx.x, lane = tid & 63, w = __builtin_amdgcn_readfirstlane(tid >> 6), fr = lane & 15, fq = lane >> 4;
    const bf16_t* xl = (const bf16_t*)(P.ws + WS_XL); bf16_t* gg = (bf16_t*)(P.ws + WS_GG); bf16_t* a1 = (bf16_t*)(P.ws + WS_HB);
    const bf16_t* gw = (const bf16_t*)(P.ws + WS_GATEW); float* sums = (float*)((unsigned char*)P.out + OUT_SUMS);
    const float* cw = P.in[7]; const float* cb = P.in[8]; const float* ba = P.in[10]; const float* bx = P.in[12]; const float* spp = (const float*)(P.ws + WS_SP);
    LAS float* CW = (LAS float*)(lds + LR_CW);
    int jb_lds = -1;
    auto dma_x = [&](int it_) {
        const int t0n = (it_ >> 3) * 64, jbn = it_ & 7;
#pragma unroll
        for (int i = 0; i < 3; ++i) {
            int p = (i * 8 + w) * 64 + lane; p = p < 67 * 21 ? p : 67 * 21 - 1;
            const int row = p / 21, c16 = p - row * 21; int tg = t0n - 3 + row; tg = tg < 0 ? 0 : tg;
            __builtin_amdgcn_global_load_lds((const unsigned*)(xl + (size_t)tg * LW + jbn * 168 + c16 * 8), (LAS unsigned*)(lds + LR_XN + (i * 8 + w) * 1024), 16, 0, 0);
        }
    };
    if ((int)blockIdx.x < 2048) dma_x((int)blockIdx.x);
    for (int item = blockIdx.x; item < 2048; item += gridDim.x) {
        const int tile = item >> 3, jb = item & 7, t0 = tile * 64;
        if (jb != jb_lds) {
            __syncthreads();
            for (int e = tid; e < 8 * 168; e += 512) { const int r = e / 168, c = e - r * 168, chn = jb * 168 + c;
                CW[r * 176 + c] = r < 4 ? cw[r * LW + chn] : (r == 4 ? cb[chn] : (r == 5 ? ba[chn] : (r == 6 ? bx[chn] : spp[chn]))); }
            jb_lds = jb;
            __syncthreads();
        }
        const bf16_t* waT = gw + (size_t)(jb * 2) * 192 * 192; const bf16_t* wxT = waT + 192 * 192;
        bf16x8 aA[6], aX[6];
        { const int m = w >> 1;
#pragma unroll
          for (int kk = 0; kk < 6; ++kk) { aA[kk] = *(const bf16x8*)(waT + (16 * m + fr) * 192 + 32 * kk + 8 * fq); aX[kk] = *(const bf16x8*)(wxT + (16 * m + fr) * 192 + 32 * kk + 8 * fq); } }
        uint4 ggpre[3];
#pragma unroll
        for (int it = 0; it < 3; ++it) { const int wi = tid + 512 * it; const int tt = wi / 21, c0 = (wi - tt * 21) * 8; ggpre[it] = wi < 64 * 21 ? *(const uint4*)(gg + (size_t)(t0 + tt) * LW + jb * 168 + c0) : make_uint4(0u, 0u, 0u, 0u); }
        asm volatile("s_waitcnt vmcnt(0)" ::: "memory"); __syncthreads();
        for (int wi = tid; wi < 64 * 24; wi += 512) {
            const int tt = wi / 24, cg8 = wi - tt * 24, c0 = cg8 * 8;
            if (cg8 < 21) {
                const int chn = jb * 168 + c0; f32x4 xa = *(const LAS f32x4*)(CW + 4 * 176 + c0), xb = *(const LAS f32x4*)(CW + 4 * 176 + c0 + 4);
#pragma unroll
                for (int d = 0; d < 4; ++d) {
                    const int tg = t0 + tt - 3 + d;
                    if (tg >= 0) { const u32x4_t xq = *(const LAS u32x4_t*)(lds + LR_XN + ((tt + d) * 21 + cg8) * 16); const uint4 xv = make_uint4(xq[0], xq[1], xq[2], xq[3]); const f32x4 wa4 = *(const LAS f32x4*)(CW + d * 176 + c0), wb4 = *(const LAS f32x4*)(CW + d * 176 + c0 + 4);
                        xa[0] += wa4[0] * __uint_as_float(xv.x << 16); xa[1] += wa4[1] * __uint_as_float(xv.x & 0xffff0000u); xa[2] += wa4[2] * __uint_as_float(xv.y << 16); xa[3] += wa4[3] * __uint_as_float(xv.y & 0xffff0000u);
                        xb[0] += wb4[0] * __uint_as_float(xv.z << 16); xb[1] += wb4[1] * __uint_as_float(xv.z & 0xffff0000u); xb[2] += wb4[2] * __uint_as_float(xv.w << 16); xb[3] += wb4[3] * __uint_as_float(xv.w & 0xffff0000u); }
                }
                u32x4_t pw; pw[0] = pg8::cvt_pk_bf16(xa[0], xa[1]); pw[1] = pg8::cvt_pk_bf16(xa[2], xa[3]); pw[2] = pg8::cvt_pk_bf16(xb[0], xb[1]); pw[3] = pg8::cvt_pk_bf16(xb[2], xb[3]);
                *(LAS u32x4_t*)(lds + LR_XCB + tt * XCB_RS + c0 * 2) = pw;
                *(LAS f32x4*)(lds + LR_XCF + tt * XCF_RS + c0 * 4) = xa; *(LAS f32x4*)(lds + LR_XCF + tt * XCF_RS + c0 * 4 + 16) = xb;
            } else { *(LAS u32x4_t*)(lds + LR_XCB + tt * XCB_RS + c0 * 2) = (u32x4_t){0u, 0u, 0u, 0u}; }
        }
        __syncthreads();
        if (item + (int)gridDim.x < 2048) dma_x(item + (int)gridDim.x);
        for (int un = w; un < 22; un += 8) {
            const int m = un >> 1, nh = un & 1; const int c0 = 16 * m + 4 * fq; const bool cv = c0 < 168; const int chn = jb * 168 + (cv ? c0 : 0);
            const int c0s = cv ? c0 : 0; const f32x4 bav = *(const LAS f32x4*)(CW + 5 * 176 + c0s), bxv = *(const LAS f32x4*)(CW + 6 * 176 + c0s), spv = *(const LAS f32x4*)(CW + 7 * 176 + c0s);
            f32x4 accA[2], accX[2];
#pragma unroll
            for (int nn = 0; nn < 2; ++nn) { accA[nn] = (f32x4){0.f, 0.f, 0.f, 0.f}; accX[nn] = accA[nn]; }
#pragma unroll
            for (int kk = 0; kk < 6; ++kk)
#pragma unroll
                for (int nn = 0; nn < 2; ++nn) { const bf16x8 bfr = *(const LAS bf16x8*)(lds + LR_XCB + (16 * (2 * nh + nn) + fr) * XCB_RS + (32 * kk + 8 * fq) * 2); accA[nn] = MFMA16(aA[kk], bfr, accA[nn]); accX[nn] = MFMA16(aX[kk], bfr, accX[nn]); }
            if (un + 8 < 22) { const int m2 = (un + 8) >> 1;
#pragma unroll
                for (int kk = 0; kk < 6; ++kk) { aA[kk] = *(const bf16x8*)(waT + (16 * m2 + fr) * 192 + 32 * kk + 8 * fq); aX[kk] = *(const bf16x8*)(wxT + (16 * m2 + fr) * 192 + 32 * kk + 8 * fq); } }
            if (cv) {
#pragma unroll
                for (int nn = 0; nn < 2; ++nn) {
                    const int tt = 16 * (2 * nh + nn) + fr; const f32x4 xcv = *(const LAS f32x4*)(lds + LR_XCF + tt * XCF_RS + c0 * 4); f32x4 av, uv;
#pragma unroll
                    for (int jj = 0; jj < 4; ++jj) {
                        const float r = __builtin_amdgcn_rcpf(1.0f + __expf(-(accA[nn][jj] + bav[jj]))), ig = __builtin_amdgcn_rcpf(1.0f + __expf(-(accX[nn][jj] + bxv[jj])));
                        const float a = __expf(-8.0f * r * spv[jj]); av[jj] = a; uv[jj] = sqrtf(fmaxf(1.0f - a * a, 0.f)) * (ig * xcv[jj]);
                    }
                    *(LAS f32x4*)(lds + LR_AA + tt * XCF_RS + c0 * 4) = av; *(LAS f32x4*)(lds + LR_XCF + tt * XCF_RS + c0 * 4) = uv;
                }
            }
        }
        __syncthreads();
        LAS float* PE = (LAS float*)(lds + LR_PE); LAS float* HE = PE + 3 * 168;
        if (tid < 504) {
            const int part = tid / 168, c = tid - part * 168, tb = part * 22, nst = part == 2 ? 20 : 22; float hs = 0.f, pp = 1.f;
            LAS unsigned char* pa0 = lds + LR_AA + tb * XCF_RS + c * 4; LAS unsigned char* pu0 = lds + LR_XCF + tb * XCF_RS + c * 4;
            float av[22], uv[22];
#pragma unroll
            for (int i = 0; i < 22; ++i) if (i < nst) { av[i] = *(const LAS float*)(pa0 + i * XCF_RS); uv[i] = *(const LAS float*)(pu0 + i * XCF_RS); }
#pragma unroll
            for (int i = 0; i < 22; ++i) if (i < nst) { hs = av[i] * hs + uv[i]; pp *= av[i]; uv[i] = hs; av[i] = pp; }
#pragma unroll
            for (int i = 0; i < 22; ++i) if (i < nst) { *(LAS float*)(pu0 + i * XCF_RS) = uv[i]; *(LAS float*)(pa0 + i * XCF_RS) = av[i]; }
            PE[tid] = pp; HE[tid] = hs;
        }
        __syncthreads();
#pragma unroll
        for (int it = 0; it < 3; ++it) {
            const int wi = tid + 512 * it; if (wi >= 64 * 21) break;
            const int tt = wi / 21, c0 = (wi - tt * 21) * 8; const int part = tt >= 44 ? 2 : (tt >= 22 ? 1 : 0);
            float hl[8], pl[8], chh[8], cpp[8];
            { const f32x4 x0 = *(const LAS f32x4*)(lds + LR_XCF + tt * XCF_RS + c0 * 4), x1 = *(const LAS f32x4*)(lds + LR_XCF + tt * XCF_RS + c0 * 4 + 16);
              const f32x4 y0 = *(const LAS f32x4*)(lds + LR_AA + tt * XCF_RS + c0 * 4), y1 = *(const LAS f32x4*)(lds + LR_AA + tt * XCF_RS + c0 * 4 + 16);
#pragma unroll
              for (int i = 0; i < 4; ++i) { hl[i] = x0[i]; hl[4 + i] = x1[i]; pl[i] = y0[i]; pl[4 + i] = y1[i]; } }
#pragma unroll
            for (int i = 0; i < 8; ++i) {
                const float p0 = PE[c0 + i], h0 = HE[c0 + i], p1 = PE[168 + c0 + i], h1v = HE[168 + c0 + i];
                chh[i] = part == 0 ? 0.f : (part == 1 ? h0 : p1 * h0 + h1v); cpp[i] = part == 0 ? 1.f : (part == 1 ? p0 : p0 * p1);
            }
            const int chn = jb * 168 + c0; const size_t gi = (size_t)(t0 + tt) * LW + chn;
            const uint4 gv = ggpre[it]; const unsigned gw4[4] = {gv.x, gv.y, gv.z, gv.w}; unsigned o1[4], o2[4];
#pragma unroll
            for (int i = 0; i < 4; ++i) {
                const float g0 = __uint_as_float(gw4[i] << 16), g1 = __uint_as_float(gw4[i] & 0xffff0000u);
                o1[i] = pg8::cvt_pk_bf16((hl[2 * i] + pl[2 * i] * chh[2 * i]) * g0, (hl[2 * i + 1] + pl[2 * i + 1] * chh[2 * i + 1]) * g1);
                o2[i] = pg8::cvt_pk_bf16(pl[2 * i] * cpp[2 * i] * g0, pl[2 * i + 1] * cpp[2 * i + 1] * g1);
            }
            *(uint4*)(a1 + (size_t)(t0 + tt) * LWP + chn) = make_uint4(o1[0], o1[1], o1[2], o1[3]);
            *(uint4*)(gg + gi) = make_uint4(o2[0], o2[1], o2[2], o2[3]);
        }
        if (tid < 168) {
            const float p0 = PE[tid], h0 = HE[tid], p1 = PE[168 + tid], h1v = HE[168 + tid], p2 = PE[336 + tid], h2 = HE[336 + tid];
            const int chn = jb * 168 + tid;
            sums[((size_t)chn * 256 + tile) * 2] = p0 * p1 * p2; sums[((size_t)chn * 256 + tile) * 2 + 1] = (h0 * p1 + h1v) * p2 + h2;
        }
        __syncthreads();
    }
}
__device__ void lru_pass2(const Params& P) {
    const int lane = threadIdx.x & 63, w = threadIdx.x >> 6;
    const float* sums = (const float*)((unsigned char*)P.out + OUT_SUMS); float* carry = (float*)((unsigned char*)P.out + OUT_CARRY);
    for (int chn = blockIdx.x * 8 + w; chn < LW; chn += gridDim.x * 8) {
        const f32x4 s0 = *(const f32x4*)(sums + ((size_t)chn * 256 + 4 * lane) * 2), s1 = *(const f32x4*)(sums + ((size_t)chn * 256 + 4 * lane) * 2 + 4);
        const float p[4] = {s0[0], s0[2], s1[0], s1[2]}, hh[4] = {s0[1], s0[3], s1[1], s1[3]};
        float Pa = 1.f, Ha = 0.f;
#pragma unroll
        for (int i = 0; i < 4; ++i) { Ha = p[i] * Ha + hh[i]; Pa *= p[i]; }
#pragma unroll
        for (int d = 1; d < 64; d <<= 1) { const float Pp = __shfl_up(Pa, d), Hp = __shfl_up(Ha, d); if (lane >= d) { Ha = Pa * Hp + Ha; Pa = Pa * Pp; } }
        float c = __shfl_up(Ha, 1); if (lane == 0) c = 0.f;
#pragma unroll
        for (int i = 0; i < 4; ++i) { carry[(size_t)(4 * lane + i) * LW + chn] = c; c = p[i] * c + hh[i]; }
    }
}
__device__ void lru_pass3(const Params& P) {
    bf16_t* a1 = (bf16_t*)(P.ws + WS_HB); const bf16_t* a2 = (const bf16_t*)(P.ws + WS_GG); const float* carry = (const float*)((unsigned char*)P.out + OUT_CARRY);
    const int nthr = gridDim.x * blockDim.x;
    for (int idx = blockIdx.x * blockDim.x + threadIdx.x; idx < SEQ * 176; idx += nthr) {
        const int t = idx / 176, g8 = idx % 176, c0 = g8 * 8; bf16_t* dst = a1 + (size_t)t * LWP + c0;
        if (g8 >= 168) { *(uint4*)dst = make_uint4(0u, 0u, 0u, 0u); continue; }
        const uint4 x1 = *(const uint4*)dst, x2 = *(const uint4*)(a2 + (size_t)t * LW + c0);
        const f32x4 ca = *(const f32x4*)(carry + (size_t)(t >> 6) * LW + c0), cbv = *(const f32x4*)(carry + (size_t)(t >> 6) * LW + c0 + 4);
        const unsigned w1[4] = {x1.x, x1.y, x1.z, x1.w}, w2[4] = {x2.x, x2.y, x2.z, x2.w}; const float cc[8] = {ca[0], ca[1], ca[2], ca[3], cbv[0], cbv[1], cbv[2], cbv[3]};
        unsigned o[4];
#pragma unroll
        for (int i = 0; i < 4; ++i) {
            const float lo = __uint_as_float(w1[i] << 16) + __uint_as_float(w2[i] << 16) * cc[2 * i], hi = __uint_as_float(w1[i] & 0xffff0000u) + __uint_as_float(w2[i] & 0xffff0000u) * cc[2 * i + 1];
            o[i] = pg8::cvt_pk_bf16(lo, hi);
        }
        *(uint4*)dst = make_uint4(o[0], o[1], o[2], o[3]);
    }
}

#define XB_XCNT(j)  (256  + 64 * (j))
#define XB_XSUB(j)  (1280 + 64 * (j))
#define XB_XGEN(j)  (2304 + 64 * (j))
#define XB_TOP      3328
#define XB_TOPGEN   3392
#define XCD_BAR_WORDS 3456
constexpr size_t WS_BAR = 255 * MiB + 512 * 1024;
constexpr int LDS_BARST = LDS_BYTES - 64;
__device__ __forceinline__ unsigned xb_ld(unsigned* p)              { return __hip_atomic_load(p, __ATOMIC_RELAXED, __HIP_MEMORY_SCOPE_AGENT); }
__device__ __forceinline__ unsigned xb_add(unsigned* p, unsigned v) { return __hip_atomic_fetch_add(p, v, __ATOMIC_RELAXED, __HIP_MEMORY_SCOPE_AGENT); }
__device__ __forceinline__ unsigned xb_xcc_id() { return (unsigned)__builtin_amdgcn_s_getreg((3 << 11) | 20) & 0xFu; }
__device__ __forceinline__ void gbar(unsigned* bar, volatile PG8_LAS unsigned* st, unsigned k) {
    asm volatile("s_waitcnt vmcnt(0)" ::: "memory");
    __syncthreads();
    if (threadIdx.x == 0) {
        const unsigned x = xb_xcc_id(), nloc = st[0], nx = st[1];
        const unsigned old = xb_add(&bar[XB_XSUB(x)], 1u);
        if (old + 1u == (k + 1u) * nloc) {
            __builtin_amdgcn_fence(__ATOMIC_RELEASE, "agent");
            asm volatile("s_waitcnt vmcnt(0)" ::: "memory");
            const unsigned og = xb_add(&bar[XB_TOP], 1u);
            if (og + 1u == (k + 1u) * nx) xb_add(&bar[XB_TOPGEN], 1u);
            else while (xb_ld(&bar[XB_TOPGEN]) == k) __builtin_amdgcn_s_sleep(1);
            __builtin_amdgcn_fence(__ATOMIC_ACQUIRE, "agent");
            xb_add(&bar[XB_XGEN(x)], 1u);
            asm volatile("s_waitcnt vmcnt(0)" ::: "memory");
        } else {
            while (xb_ld(&bar[XB_XGEN(x)]) == k) __builtin_amdgcn_s_sleep(1);
            __builtin_amdgcn_fence(__ATOMIC_ACQUIRE, "agent");
            asm volatile("s_waitcnt vmcnt(0)" ::: "memory");
        }
    }
    __syncthreads();
}
template <class Epi> __device__ __forceinline__ void run_gemm(PG8_LAS unsigned char* lds, const bf16_t* A, const bf16_t* Bt, int M, int N, int K, const Epi& E, int a_tile_rows = 256, int stagger = 0) {
    if (stagger) { const unsigned long long t0 = wall_clock64(), d = (unsigned long long)(((blockIdx.x >> 3) & 3) * stagger); while (wall_clock64() - t0 < d) __builtin_amdgcn_s_sleep(4); }
    pg8::Gemm g{A, Bt, M, N, K, a_tile_rows}; pg8::StaticOrder S; S.init(M, N, (int)gridDim.x, (int)blockIdx.x);
    pg8::gemm_phase<Epi, pg8::StaticOrder, false>(lds, g, S, E, nullptr);
}

__global__ void __launch_bounds__(512, 2) fwd_megakernel(Params P) {
    extern __shared__ __attribute__((aligned(16))) unsigned char smem[];
    cg::grid_group grid = cg::this_grid();
    PG8_LAS unsigned char* lds = (PG8_LAS unsigned char*)smem;
    if (threadIdx.x == 0) (void)xb_add((unsigned*)(P.ws + WS_BAR) + XB_XCNT(xb_xcc_id()), 1u);
    if (P.out == nullptr) grid.sync();
    unsigned char* ws = P.ws; unsigned char* ob = (unsigned char*)P.out;
    bf16_t* h1 = (bf16_t*)(ob + OUT_H1); bf16_t* sB = (bf16_t*)(ob + OUT_SB); bf16_t* yas = (bf16_t*)(ob + OUT_YAS);
    bf16_t* Wup = (bf16_t*)(ws + WS_WUP); bf16_t* Wdown = (bf16_t*)(ws + WS_WDOWN); bf16_t* Wout = (bf16_t*)(ws + WS_WOUT); bf16_t* Wglao = (bf16_t*)(ws + WS_GLAWO); bf16_t* Wlruo = (bf16_t*)(ws + WS_LRUWO); bf16_t* Win = (bf16_t*)(ws + WS_WIN);
    float* rowsq = (float*)(ws + WS_ROWSQ);

#ifndef PROBE_A
#define PROBE_A -1
#define PROBE_B -1
#endif
    unsigned long long tA = 0, tB = 0; unsigned bar_k = 0;
#define STAMP(k) do { if ((k) == PROBE_A) tA = wall_clock64(); if ((k) == PROBE_B) tB = wall_clock64(); } while (0)
    STAMP(0);
    rmsnorm_rows_bf16(P.in[0], P.in[1], h1);
    transpose_range<0, 1984>(P, (float*)smem, (int)blockIdx.x, (int)gridDim.x);
    transpose_range<5152, NTILES_ALL>(P, (float*)smem, (int)blockIdx.x, (int)gridDim.x);
    for (int i = blockIdx.x * blockDim.x + threadIdx.x; i < SEQ; i += gridDim.x * blockDim.x) rowsq[i] = 0.f;
    for (int i = blockIdx.x * blockDim.x + threadIdx.x; i < LW; i += gridDim.x * blockDim.x) { const float av = P.in[13][i]; ((float*)(ws + WS_SP))[i] = fmaxf(av, 0.f) + log1pf(__expf(-fabsf(av))); }
    if (threadIdx.x == 0) {
        unsigned mine, cnt; const unsigned x = xb_xcc_id();
        for (;;) { unsigned sum = 0u; mine = 0u; cnt = 0u;
            for (unsigned j = 0; j < 16; ++j) { const unsigned c = xb_ld((unsigned*)(P.ws + WS_BAR) + XB_XCNT(j)); sum += c; cnt += c > 0u ? 1u : 0u; mine = j == x ? c : mine; }
            if (sum == gridDim.x) break;
            __builtin_amdgcn_s_sleep(2); }
        ((volatile PG8_LAS unsigned*)(lds + LDS_BARST))[0] = mine; ((volatile PG8_LAS unsigned*)(lds + LDS_BARST))[1] = cnt;
    }
    __syncthreads();
    gbar((unsigned*)(P.ws + WS_BAR), (volatile PG8_LAS unsigned*)(lds + LDS_BARST), bar_k++);
    STAMP(1);
    { EpiGen<F1> E{F1{(bf16_t*)(ws + WS_Q), (bf16_t*)(ws + WS_K), (bf16_t*)(ws + WS_V), (bf16_t*)(ws + WS_G), (bf16_t*)(ws + WS_SA), sB, (bf16_t*)(ws + WS_XL), (bf16_t*)(ws + WS_GG), (float*)(ws + WS_FLOW)}};
      run_gemm(lds, h1, Win, SEQ, NP, DM, E, 256, STAG); }
    gbar((unsigned*)(P.ws + WS_BAR), (volatile PG8_LAS unsigned*)(lds + LDS_BARST), bar_k++);
    STAMP(2);
#ifdef NAIVE_GLA
    gla_naive(P, (float*)smem);
    gbar((unsigned*)(P.ws + WS_BAR), (volatile PG8_LAS unsigned*)(lds + LDS_BARST), bar_k++);
#else
    gla_pass<false>(P, lds);
    gbar((unsigned*)(P.ws + WS_BAR), (volatile PG8_LAS unsigned*)(lds + LDS_BARST), bar_k++);
    STAMP(3);
    gla_scan(P);
    transpose_range<4288, 5152>(P, (float*)smem, (int)blockIdx.x, (int)gridDim.x);
    gbar((unsigned*)(P.ws + WS_BAR), (volatile PG8_LAS unsigned*)(lds + LDS_BARST), bar_k++);
    STAMP(4);
    gla_pass<true>(P, lds);
    gbar((unsigned*)(P.ws + WS_BAR), (volatile PG8_LAS unsigned*)(lds + LDS_BARST), bar_k++);
    STAMP(5);
#endif
#ifdef NAIVE_LRU
    lru_naive(P, (float*)smem);
    gbar((unsigned*)(P.ws + WS_BAR), (volatile PG8_LAS unsigned*)(lds + LDS_BARST), bar_k++);
#else
    lru_pass1(P, lds);
    gbar((unsigned*)(P.ws + WS_BAR), (volatile PG8_LAS unsigned*)(lds + LDS_BARST), bar_k++);
    STAMP(6);
    lru_pass2(P);
    transpose_range<1984, 3520>(P, (float*)smem, (int)blockIdx.x, (int)gridDim.x);
    gbar((unsigned*)(P.ws + WS_BAR), (volatile PG8_LAS unsigned*)(lds + LDS_BARST), bar_k++);
    STAMP(7);
    lru_pass3(P);
    gbar((unsigned*)(P.ws + WS_BAR), (volatile PG8_LAS unsigned*)(lds + LDS_BARST), bar_k++);
    STAMP(8);
#endif
    { EpiGen<F2> E{F2{(const bf16_t*)(ws + WS_SA), yas}}; run_gemm(lds, (const bf16_t*)(ws + WS_G), Wglao, SEQ, DM, DM, E); }
    { EpiGen<F3> E{F3{sB, yas, (bf16_t*)(ws + WS_MERGED)}}; run_gemm(lds, (const bf16_t*)(ws + WS_HB), Wlruo, SEQ, DM, LWP, E); }
    gbar((unsigned*)(P.ws + WS_BAR), (volatile PG8_LAS unsigned*)(lds + LDS_BARST), bar_k++);
    STAMP(9);
    if (blockIdx.x == 0) for (int i = threadIdx.x; i < 2 * DM / 2; i += 512) ((unsigned*)(ws + WS_X1B))[i] = 0u;
    { E4 E{P.in[0], P.out, (bf16_t*)(ws + WS_X1B), rowsq}; run_gemm(lds, (const bf16_t*)(ws + WS_MERGED), Wout, SEQ, DM, DM, E); }
    gbar((unsigned*)(P.ws + WS_BAR), (volatile PG8_LAS unsigned*)(lds + LDS_BARST), bar_k++);
    STAMP(10);
    { E5f E{rowsq, P.in[18], P.in[19], (bf16_t*)(ws + WS_ACT), (PG8_LAS float*)(lds + XCH_OFF)}; run_gemm(lds, (const bf16_t*)(ws + WS_X1B), Wup, 65 * 256, 2 * DFF, DM, E, 254, STAG);
      transpose_in_idle_slot<3520, 4288>(P, (float*)smem, 65 * 24); }
    gbar((unsigned*)(P.ws + WS_BAR), (volatile PG8_LAS unsigned*)(lds + LDS_BARST), bar_k++);
    STAMP(14);
    { E6 E{P.out, (const bf16_t*)(ws + WS_X1B)}; run_gemm(lds, (const bf16_t*)(ws + WS_ACT), Wdown, SEQ, DM, DFF, E); }
    gbar((unsigned*)(P.ws + WS_BAR), (volatile PG8_LAS unsigned*)(lds + LDS_BARST), bar_k++);
    STAMP(15);
    rmsnorm_rows_inplace(P.out, P.in[21]);
    if (PROBE_A >= 0) { gbar((unsigned*)(P.ws + WS_BAR), (volatile PG8_LAS unsigned*)(lds + LDS_BARST), bar_k++); STAMP(16); if (blockIdx.x == 0 && threadIdx.x == 0) { const unsigned long long t0 = wall_clock64(); while (wall_clock64() - t0 < tB - tA) __builtin_amdgcn_s_sleep(8); } }
}

extern "C" void kernel_launch(void* const* d_in, const int* in_sizes, int n_in, void* d_out, int out_size, void* d_ws, size_t ws_size, hipStream_t stream) {
    static int grid_blocks = 0;
    if (grid_blocks == 0) {
        int dev = 0, cus = 0, per_cu = 0;
        hipGetDevice(&dev);
        hipDeviceGetAttribute(&cus, hipDeviceAttributeMultiprocessorCount, dev);
        if (hipFuncSetAttribute((const void*)fwd_megakernel, hipFuncAttributeMaxDynamicSharedMemorySize, LDS_BYTES) != hipSuccess) { fprintf(stderr, "hipFuncSetAttribute failed\n"); grid_blocks = -1; return; }
        if (hipOccupancyMaxActiveBlocksPerMultiprocessor(&per_cu, (const void*)fwd_megakernel, 512, LDS_BYTES) != hipSuccess || per_cu < 1) { fprintf(stderr, "occupancy query: %d\n", per_cu); per_cu = 1; }
        (void)hipGetLastError();
        grid_blocks = cus * per_cu;
        if (n_in != 22 || ws_size < 256 * MiB) { fprintf(stderr, "unexpected n_in %d / ws_size %zu\n", n_in, ws_size); }
    }
    if (grid_blocks < 0) return;
    Params p{};
    for (int i = 0; i < 22; ++i) p.in[i] = (const float*)d_in[i];
    p.out = (float*)d_out; p.ws = (unsigned char*)d_ws;
    if (hipMemsetAsync((unsigned char*)d_ws + WS_BAR, 0, XCD_BAR_WORDS * sizeof(unsigned), stream) != hipSuccess) { fprintf(stderr, "memset of barrier words failed\n"); return; }
    void* args[] = {&p};
    hipError_t e = hipLaunchCooperativeKernel((const void*)fwd_megakernel, dim3(grid_blocks), dim3(512), args, LDS_BYTES, stream);
    if (e != hipSuccess) fprintf(stderr, "cooperative launch failed: %s (grid %d)\n", hipGetErrorString(e), grid_blocks);
}
```

```cpp
#include <hip/hip_runtime.h>
#include <hip/hip_cooperative_groups.h>
#include <cstdio>
namespace cg = cooperative_groups;
namespace pg8 {
#define PG8_LAS __attribute__((address_space(3)))
typedef unsigned short bf16_t;
typedef short bf16x8 __attribute__((ext_vector_type(8)));
typedef float f32x4 __attribute__((ext_vector_type(4)));
typedef unsigned u32x4 __attribute__((ext_vector_type(4)));
constexpr int BM = 256, BK = 64, HALF = 128, HTB = HALF * BK * 2  , STAGE_BYTES = 8 * HTB, NXCD = 8, WGM = 8;

__host__ __device__ __forceinline__ int lds_byte(int r, int c) { const int st = (r >> 4) * 2 + (c >> 5), rr = r & 15, cc = c & 31, ob = rr * 64 + cc * 2; return st * 1024 + (ob ^ (((ob >> 9) & 1) << 5)); }
__host__ __device__ __forceinline__ void stage_rc(int b, int& R, int& C) { const int st = b / 1024, sb = b % 1024, swz = sb ^ (((sb >> 9) & 1) << 5); R = (st >> 1) * 16 + swz / 64; C = (st & 1) * 32 + (swz % 64) / 2; }
__host__ __device__ __forceinline__ int perm32(int rho) { const int n = rho >> 4, i = rho & 15; return 8 * (i >> 2) + 4 * n + (i & 3); }

struct Unit { int pm, pn; };
struct Gemm { const bf16_t* A; const bf16_t* Bt; int M, N, K; int a_tile_rows; };

struct StaticOrder {
    int nM, nN, nwg, G, c;
    __host__ __device__ void init(int M, int N, int G_, int c_) { nM = M / BM; nN = N / BM; nwg = nM * nN; G = G_; c = c_; }
    __host__ __device__ bool next(int i, Unit& u) const {
        const long L = (long)i * G + c; if (L >= nwg) return false;
        int wgid = (int)L; { const int q = nwg / NXCD, r = nwg % NXCD, xcd = wgid % NXCD, off = wgid / NXCD; wgid = (xcd < r ? xcd * (q + 1) : r * (q + 1) + (xcd - r) * q) + off; }
        const int nig = WGM * nN, gid = wgid / nig, fm = gid * WGM, gsz = (nM - fm) < WGM ? (nM - fm) : WGM;
        u.pm = fm + ((wgid % nig) % gsz); u.pn = (wgid % nig) / gsz; return true;
    }
    __device__ __forceinline__ void a_ready(const Unit&) const {}
    __device__ __forceinline__ void done(const Unit&) const {}
};
__device__ __forceinline__ unsigned cvt_pk_bf16(float lo, float hi) { unsigned r; asm volatile("v_cvt_pk_bf16_f32 %0, %1, %2" : "=v"(r) : "v"(lo), "v"(hi)); return r; }
typedef float f32x2 __attribute__((ext_vector_type(2)));
template <class Epi, class Sched, bool STAMP = false>
__device__ __forceinline__ void gemm_phase(PG8_LAS unsigned char* lds, const Gemm g, const Sched& S, const Epi& E, unsigned long long* stamps) {
    const int tid = threadIdx.x, wid = __builtin_amdgcn_readfirstlane(tid >> 6), lane = tid & 63, wr = wid >> 2, wc = wid & 3, fr = lane & 15, fq = lane >> 4;
    const int K = g.K, nt = K / BK;
    int ts_lo = 0, ts_hi = 0, nts = 0; const unsigned long long rt_entry = STAMP ? (unsigned long long)wall_clock64() : 0ull;
#define PG8_STAMP() do { if (STAMP && wid == 0 && nts < 64) { const unsigned long long _c = (unsigned long long)clock64(); \
        ts_lo = (lane == nts) ? (int)(unsigned)_c : ts_lo; ts_hi = (lane == nts) ? (int)(unsigned)(_c >> 32) : ts_hi; ++nts; } } while (0)
    PG8_STAMP();
    unsigned voffA[2], voffB[2];
#pragma unroll
    for (int i = 0; i < 2; ++i) { int R, C; stage_rc(tid * 16 + i * 8192, R, C); const int Rb = Epi::PERM ? ((R & ~31) + perm32(R & 31)) : R;
        const int Ra = Epi::APERM ? ((R & 64) + 4 * (R & 15) + ((R >> 4) & 3)) : R;
        voffA[i] = (unsigned)(Ra * K + C) * 2u; voffB[i] = (unsigned)(Rb * K + C) * 2u; }
    const size_t kstep = (size_t)(BK * 2);
    const size_t hstep = (size_t)HALF * K * 2;
    const size_t tstep = 2 * hstep; const size_t tstepA = (size_t)g.a_tile_rows * K * 2;
    const unsigned ldsw = (unsigned)wid * 1024u;
    const int aoff = lds_byte(wr * 64 + fr, fq * 8), boff = lds_byte(wc * 32 + fr, fq * 8);
#define PG8_SA(b, h) (((b) * 2 + (h)) * HTB)
#define PG8_SB(b, h) ((4 + (b) * 2 + (h)) * HTB)
#define PG8_STAGE(bufoff, gbase, voff) do { _Pragma("unroll") for (int _i = 0; _i < 2; ++_i) \
        __builtin_amdgcn_global_load_lds((const unsigned*)((const char*)(gbase) + (voff)[_i]), (PG8_LAS unsigned*)(lds + (bufoff) + ldsw + _i * 8192), 16, 0, 0); } while (0)
#define PG8_LDA(dst, b, h) do { _Pragma("unroll") for (int m = 0; m < 4; ++m) _Pragma("unroll") for (int k = 0; k < 2; ++k) dst[m][k] = *(const PG8_LAS bf16x8*)(lds + PG8_SA(b, h) + aoff + m * 2048 + k * 1024); } while (0)
#define PG8_LDB(dst, b, h) do { _Pragma("unroll") for (int n = 0; n < 2; ++n) _Pragma("unroll") for (int k = 0; k < 2; ++k) dst[n][k] = *(const PG8_LAS bf16x8*)(lds + PG8_SB(b, h) + boff + n * 2048 + k * 1024); } while (0)
#define PG8_MMA(ai, bj, At, Bt) do { __builtin_amdgcn_s_setprio(1); _Pragma("unroll") for (int m = 0; m < 4; ++m) _Pragma("unroll") for (int n = 0; n < 2; ++n) _Pragma("unroll") for (int k = 0; k < 2; ++k) \
        acc[ai][bj][m][n] = __builtin_amdgcn_mfma_f32_16x16x32_bf16(Bt[n][k], At[m][k], acc[ai][bj][m][n], 0, 0, 0); __builtin_amdgcn_s_setprio(0); } while (0)
#define PG8_WAIT_V(n) asm volatile("s_waitcnt vmcnt(" #n ")" ::: "memory")
#define PG8_WAIT_L(n) asm volatile("s_waitcnt lgkmcnt(" #n ")" ::: "memory")
#define PG8_BAR __builtin_amdgcn_s_barrier()
#define PG8_SCHED __builtin_amdgcn_sched_barrier(0)
    Unit cur, nxt; int ui = 0;
    if (!S.next(0, cur)) return;
    f32x4 acc[2][2][4][2];
#pragma unroll
    for (int a = 0; a < 2; ++a)
#pragma unroll
        for (int b = 0; b < 2; ++b)
#pragma unroll
            for (int m = 0; m < 4; ++m)
#pragma unroll
                for (int n = 0; n < 2; ++n) acc[a][b][m][n] = (f32x4){0.f, 0.f, 0.f, 0.f};
    if constexpr (Epi::HAS_INIT) E.init(acc, cur, wr, wc, fr, fq);
    bf16x8 At[4][2], B0[2][2], B1[2][2];
    const char* cA = (const char*)g.A + (size_t)cur.pm * tstepA; const char* cB = (const char*)g.Bt + (size_t)cur.pn * tstep;
    S.a_ready(cur);
    PG8_STAGE(PG8_SB(0, 0), cB, voffB); PG8_STAGE(PG8_SA(0, 0), cA, voffA); PG8_STAGE(PG8_SB(0, 1), cB + hstep, voffB); PG8_STAGE(PG8_SA(0, 1), cA + hstep, voffA);
    if (wr == 1) PG8_BAR;
    PG8_WAIT_V(4); PG8_BAR;
    PG8_STAGE(PG8_SB(1, 0), cB + kstep, voffB); PG8_STAGE(PG8_SA(1, 0), cA + kstep, voffA); PG8_STAGE(PG8_SB(1, 1), cB + hstep + kstep, voffB);
    PG8_WAIT_V(6); PG8_BAR;
    PG8_STAMP();
    for (;;) {
        const bool has_next = S.next(ui + 1, nxt);
        const char* nA = has_next ? (const char*)g.A + (size_t)nxt.pm * tstepA : cA; const char* nB = has_next ? (const char*)g.Bt + (size_t)nxt.pn * tstep : cB;
        for (int t = 0; t < nt; t += 2) {
            const bool last = (t == nt - 2);
            const char* a1 = cA + (size_t)(t + 1) * kstep;
            const char* a2 = last ? nA : cA + (size_t)(t + 2) * kstep; const char* b2 = last ? nB : cB + (size_t)(t + 2) * kstep;
            const char* a3 = a2 + kstep; const char* b3 = b2 + kstep;
            if (last && has_next) S.a_ready(nxt);
            PG8_LDB(B0, 0, 0); PG8_SCHED; PG8_LDA(At, 0, 0); PG8_STAGE(PG8_SA(1, 1), a1 + hstep, voffA);
            PG8_WAIT_L(8); PG8_BAR; PG8_WAIT_L(0); PG8_MMA(0, 0, At, B0); PG8_BAR; PG8_SCHED;
            PG8_LDB(B1, 0, 1); PG8_STAGE(PG8_SB(0, 0), b2, voffB);
            PG8_BAR; PG8_WAIT_L(0); PG8_MMA(0, 1, At, B1); PG8_BAR;
            PG8_LDA(At, 0, 1); PG8_STAGE(PG8_SA(0, 0), a2, voffA);
            PG8_BAR; PG8_WAIT_L(0); PG8_MMA(1, 0, At, B0); PG8_BAR; PG8_SCHED;
            PG8_STAGE(PG8_SB(0, 1), b2 + hstep, voffB);
            PG8_WAIT_V(6); PG8_BAR; PG8_MMA(1, 1, At, B1); PG8_BAR;
            PG8_LDB(B0, 1, 0); PG8_SCHED; PG8_LDA(At, 1, 0); PG8_STAGE(PG8_SA(0, 1), a2 + hstep, voffA);
            PG8_WAIT_L(8); PG8_BAR; PG8_WAIT_L(0); PG8_MMA(0, 0, At, B0); PG8_BAR; PG8_SCHED;
            PG8_LDB(B1, 1, 1); PG8_STAGE(PG8_SB(1, 0), b3, voffB);
            PG8_BAR; PG8_WAIT_L(0); PG8_MMA(0, 1, At, B1); PG8_BAR;
            PG8_LDA(At, 1, 1); PG8_STAGE(PG8_SA(1, 0), a3, voffA);
            PG8_BAR; PG8_WAIT_L(0); PG8_MMA(1, 0, At, B0); PG8_BAR; PG8_SCHED;
            PG8_STAGE(PG8_SB(1, 1), b3 + hstep, voffB);
            PG8_WAIT_V(6); PG8_BAR; PG8_MMA(1, 1, At, B1); PG8_BAR;
        }
        PG8_STAMP();
        if constexpr (!Epi::AFTER_DRAIN) { E(acc, cur, wr, wc, fr, fq); S.done(cur); }
        PG8_STAMP();
        if (!has_next) break;
#pragma unroll
        for (int a = 0; a < 2; ++a)
#pragma unroll
            for (int b = 0; b < 2; ++b)
#pragma unroll
                for (int m = 0; m < 4; ++m)
#pragma unroll
                    for (int n = 0; n < 2; ++n) acc[a][b][m][n] = (f32x4){0.f, 0.f, 0.f, 0.f};
        cur = nxt; cA = nA; cB = nB; ++ui;
    }
    PG8_WAIT_V(0);
    if (wr == 0) PG8_BAR;
    PG8_BAR;
    if constexpr (Epi::AFTER_DRAIN) { E.fused(acc, cur, wr, wc, fr, fq, lds, wid, lane); S.done(cur); }
    PG8_STAMP();
    if (STAMP && wid == 0) { stamps[lane] = lane < nts ? (((unsigned long long)(unsigned)ts_hi << 32) | (unsigned)ts_lo) : 0ull;
        if (lane == 62) stamps[62] = rt_entry; if (lane == 63) stamps[63] = (unsigned long long)wall_clock64(); }
#undef PG8_STAMP
#undef PG8_SA
#undef PG8_SB
#undef PG8_STAGE
#undef PG8_LDA
#undef PG8_LDB
#undef PG8_MMA
#undef PG8_WAIT_V
#undef PG8_WAIT_L
#undef PG8_BAR
#undef PG8_SCHED
}
}

typedef pg8::bf16_t bf16_t;
typedef pg8::f32x4 f32x4;
constexpr int SEQ = 16384, DM = 1024, NP = 7936, LW = 1344, LWP = 1408, DFF = 3072;
constexpr size_t MiB = (size_t)1 << 20;
constexpr size_t WS_WUP = 0, WS_WDOWN = 12 * MiB, WS_WOUT = 18 * MiB, WS_GLAWO = 20 * MiB, WS_LRUWO = 22 * MiB, WS_MISC = 25 * MiB, WS_WIN = 26 * MiB;
constexpr size_t WS_Q = 42 * MiB, WS_K = 58 * MiB, WS_V = 74 * MiB, WS_G = 106 * MiB, WS_XL = 138 * MiB, WS_GG = 180 * MiB, WS_SA = 222 * MiB, WS_FLOW = 254 * MiB, WS_ROWSQ = 255 * MiB;
constexpr size_t WS_HB = WS_Q;
constexpr size_t WS_MERGED = WS_XL;
constexpr size_t WS_X1B = 20 * MiB;
constexpr size_t WS_U = 52 * MiB;
constexpr size_t WS_HSAVE = 148 * MiB;
constexpr size_t WS_ACT = 56 * MiB;
constexpr size_t OUT_H1 = 0, OUT_SB = 32 * MiB, OUT_YAS = 0;
constexpr int LDS_BYTES = 160 * 1024;

#ifndef STAG
#define STAG 0
#endif
struct Params { const float* in[22]; float* out; unsigned char* ws; };

__device__ __forceinline__ float bf2f(bf16_t b) { return __uint_as_float(((unsigned)b) << 16); }
__device__ __forceinline__ void st4(bf16_t* p, f32x4 a) { uint2 w; w.x = pg8::cvt_pk_bf16(a[0], a[1]); w.y = pg8::cvt_pk_bf16(a[2], a[3]); *(uint2*)p = w; }
__device__ __forceinline__ f32x4 ld4(const bf16_t* p) { const uint2 w = *(const uint2*)p; f32x4 r; r[0] = __uint_as_float(w.x << 16); r[1] = __uint_as_float(w.x & 0xffff0000u); r[2] = __uint_as_float(w.y << 16); r[3] = __uint_as_float(w.y & 0xffff0000u); return r; }
__device__ __forceinline__ float sigm(float x) { return __builtin_amdgcn_rcpf(1.f + __builtin_amdgcn_exp2f(-1.4426950408889634f * x)); }
__device__ __forceinline__ float gelu_t(float x) { const float y = x * (-2.302208198f + -0.10294324f * x * x); return x * __builtin_amdgcn_rcpf(1.f + __builtin_amdgcn_exp2f(y)); }
__device__ __forceinline__ float wave_sum(float s) {
#pragma unroll
    for (int o = 32; o >= 1; o >>= 1) s += __shfl_xor(s, o);
    return s;
}

__device__ void rmsnorm_rows_bf16(const float* x, const float* g, bf16_t* out) {
    const int wave = threadIdx.x >> 6, lane = threadIdx.x & 63;
    for (int row = blockIdx.x * 8 + wave; row < SEQ; row += gridDim.x * 8) {
        const float* xr = x + (size_t)row * DM; f32x4 v[4]; float ss = 0.f;
#pragma unroll
        for (int i = 0; i < 4; ++i) { v[i] = *(const f32x4*)(xr + i * 256 + lane * 4); ss += v[i][0] * v[i][0] + v[i][1] * v[i][1] + v[i][2] * v[i][2] + v[i][3] * v[i][3]; }
        ss = wave_sum(ss);
        const float r = rsqrtf(ss * (1.0f / DM) + 1e-6f);
#pragma unroll
        for (int i = 0; i < 4; ++i) { const f32x4 gv = *(const f32x4*)(g + i * 256 + lane * 4); st4(out + (size_t)row * DM + i * 256 + lane * 4, v[i] * r * gv); }
    }
}
__device__ void rmsnorm_rows_inplace(float* x, const float* g) {
    const int wave = threadIdx.x >> 6, lane = threadIdx.x & 63;
    for (int row = blockIdx.x * 8 + wave; row < SEQ; row += gridDim.x * 8) {
        float* xr = x + (size_t)row * DM; f32x4 v[4]; float ss = 0.f;
#pragma unroll
        for (int i = 0; i < 4; ++i) { v[i] = *(const f32x4*)(xr + i * 256 + lane * 4); ss += v[i][0] * v[i][0] + v[i][1] * v[i][1] + v[i][2] * v[i][2] + v[i][3] * v[i][3]; }
        ss = wave_sum(ss);
        const float r = rsqrtf(ss * (1.0f / DM) + 1e-6f);
#pragma unroll
        for (int i = 0; i < 4; ++i) { const f32x4 gv = *(const f32x4*)(g + i * 256 + lane * 4); *(f32x4*)(xr + i * 256 + lane * 4) = v[i] * r * gv; }
    }
}
__device__ __forceinline__ int colmap_win(int n) {
    if (n < 3072) return n;
    if (n < 4096) return 5776 + (n - 3072);
    if (n < 5120) return 6800 + (n - 4096);
    if (n < 6464) return 3088 + (n - 5120);
    if (n < 7808) return 4432 + (n - 6464);
    if (n < 7824) return 3072 + (n - 7808);
    return -1;
}
__device__ __forceinline__ int colmap_wup(int n) { return ((n >> 7) & 1 ? DFF : 0) + 128 * (n >> 8) + (n & 127); }
constexpr size_t WS_GATEW0 = 24 * MiB + 768 * 1024;
constexpr int NTILES_ALL = 1984 + 1536 + 768 + 352 + 256 + 256 + 144;
struct TDesc { const float* src; const float* rs; bf16_t* dst; int srcK, srcLd, srcNv, dstK, tk, mode, lt; };
__device__ __forceinline__ TDesc get_desc(const Params& P, int t) {
    unsigned char* ws = P.ws; TDesc d;
    if (t < 1984) { d = TDesc{P.in[2], nullptr, (bf16_t*)(ws + WS_WIN), 1024, 7824, 7824, 1024, 16, 1, t}; }
    else if (t < 3520) { d = TDesc{P.in[17], P.in[16], (bf16_t*)(ws + WS_WUP), 1024, 6144, 6144, 1024, 16, 2, t - 1984}; }
    else if (t < 4288) { d = TDesc{P.in[20], nullptr, (bf16_t*)(ws + WS_WDOWN), 3072, 1024, 1024, 3072, 48, 0, t - 3520}; }
    else if (t < 4640) { d = TDesc{P.in[14], nullptr, (bf16_t*)(ws + WS_LRUWO), 1344, 1024, 1024, 1408, 22, 0, t - 4288}; }
    else if (t < 4896) { d = TDesc{P.in[6], nullptr, (bf16_t*)(ws + WS_GLAWO), 1024, 1024, 1024, 1024, 16, 0, t - 4640}; }
    else if (t < 5152) { d = TDesc{P.in[15], nullptr, (bf16_t*)(ws + WS_WOUT), 1024, 1024, 1024, 1024, 16, 0, t - 4896}; }
    else { const int u = t - 5152, gsel = u / 9; d = TDesc{(gsel & 1 ? P.in[11] : P.in[9]) + (size_t)(gsel >> 1) * 168 * 168, nullptr, (bf16_t*)(ws + WS_GATEW0) + (size_t)gsel * 192 * 192, 168, 168, 168, 192, 3, 0, u - gsel * 9}; }
    return d;
}
template <int lo, int hi> __device__ void transpose_range(const Params& P, float* tile, int rank, int nranks) {
    const int lane = threadIdx.x & 63, i8 = threadIdx.x >> 6, nl = threadIdx.x >> 3, kg = threadIdx.x & 7;
    for (int base = lo + rank * 2; base < hi; base += nranks * 2) {
        float val[2][8];
#pragma unroll
        for (int u = 0; u < 2; ++u) {
            const int t = base + u;
            if (t < hi) {
                __builtin_assume(t >= lo && t < hi);
                const TDesc d = get_desc(P, t); const int k0 = (d.lt % d.tk) * 64, n0 = (d.lt / d.tk) * 64, n = n0 + (lane & 15) * 4;
                const int sc = d.mode == 1 ? colmap_win(n) : (d.mode == 2 ? colmap_wup(n) : (n < d.srcNv ? n : -1));
#pragma unroll
                for (int j = 0; j < 2; ++j) { const int k = k0 + i8 * 8 + j * 4 + (lane >> 4); f32x4 x = {0.f, 0.f, 0.f, 0.f};
                    if (sc >= 0 && k < d.srcK) { x = *(const f32x4*)(d.src + (size_t)k * d.srcLd + sc); if (d.rs) x = x * d.rs[k]; }
                    val[u][4 * j] = x[0]; val[u][4 * j + 1] = x[1]; val[u][4 * j + 2] = x[2]; val[u][4 * j + 3] = x[3]; }
            }
        }
#pragma unroll
        for (int u = 0; u < 2; ++u)
#pragma unroll
            for (int j = 0; j < 8; ++j) tile[u * 4160 + (i8 * 8 + (j >> 2) * 4 + (lane >> 4)) * 65 + (lane & 15) * 4 + (j & 3)] = val[u][j];
        __syncthreads();
#pragma unroll
        for (int u = 0; u < 2; ++u) {
            const int t = base + u;
            if (t < hi) {
                __builtin_assume(t >= lo && t < hi);
                const TDesc d = get_desc(P, t); const int k0 = (d.lt % d.tk) * 64, n0 = (d.lt / d.tk) * 64;
                float f[8];
#pragma unroll
                for (int j = 0; j < 8; ++j) f[j] = tile[u * 4160 + (kg * 8 + j) * 65 + nl];
                uint4 w; w.x = pg8::cvt_pk_bf16(f[0], f[1]); w.y = pg8::cvt_pk_bf16(f[2], f[3]); w.z = pg8::cvt_pk_bf16(f[4], f[5]); w.w = pg8::cvt_pk_bf16(f[6], f[7]);
                *(uint4*)(d.dst + (size_t)(n0 + nl) * d.dstK + k0 + kg * 8) = w;
            }
        }
        __syncthreads();
    }
}
template <int lo, int hi> __device__ __forceinline__ void transpose_in_idle_slot(const Params& P, float* tile, int n_units) {
    const int G = (int)gridDim.x, r = n_units % G;
    const int rank = r == 0 ? (int)blockIdx.x : (int)blockIdx.x - r, nranks = r == 0 ? G : G - r;
    if (rank >= 0) transpose_range<lo, hi>(P, tile, rank, nranks);
}

typedef unsigned u32x4n __attribute__((ext_vector_type(4)));
#ifndef NT_STORE
#define NT_STORE 0
#endif
__device__ __forceinline__ void st8(bf16_t* p, f32x4 a, f32x4 b) { u32x4n w; w[0] = pg8::cvt_pk_bf16(a[0], a[1]); w[1] = pg8::cvt_pk_bf16(a[2], a[3]); w[2] = pg8::cvt_pk_bf16(b[0], b[1]); w[3] = pg8::cvt_pk_bf16(b[2], b[3]);
    if (NT_STORE) __builtin_nontemporal_store(w, (u32x4n*)p); else *(u32x4n*)p = w; }
__device__ __forceinline__ void ld8(const bf16_t* p, f32x4& a, f32x4& b) { const uint4 w = *(const uint4*)p; a[0] = __uint_as_float(w.x << 16); a[1] = __uint_as_float(w.x & 0xffff0000u); a[2] = __uint_as_float(w.y << 16); a[3] = __uint_as_float(w.y & 0xffff0000u);
    b[0] = __uint_as_float(w.z << 16); b[1] = __uint_as_float(w.z & 0xffff0000u); b[2] = __uint_as_float(w.w << 16); b[3] = __uint_as_float(w.w & 0xffff0000u); }
template <class F> struct EpiGen {
    static constexpr bool PERM = true, AFTER_DRAIN = false, APERM = false, HAS_INIT = false; F f;
    __device__ __forceinline__ void operator()(f32x4 (&acc)[2][2][4][2], const pg8::Unit& u, int wr, int wc, int fr, int fq) const {
#pragma unroll
        for (int ai = 0; ai < 2; ++ai)
#pragma unroll
            for (int m = 0; m < 4; ++m) { const int row = u.pm * 256 + ai * 128 + wr * 64 + m * 16 + fr;
#pragma unroll
                for (int bj = 0; bj < 2; ++bj) f(row, u.pn * 256 + bj * 128 + wc * 32 + 8 * fq, acc[ai][bj][m][0], acc[ai][bj][m][1], u.pn * 256 + bj * 128 + wc * 32); }
    }
};
__device__ __forceinline__ f32x4 sigm4(f32x4 a) { f32x4 s; s[0] = sigm(a[0]); s[1] = sigm(a[1]); s[2] = sigm(a[2]); s[3] = sigm(a[3]); return s; }
__device__ __forceinline__ f32x4 gelu4(f32x4 a) { f32x4 s; s[0] = gelu_t(a[0]); s[1] = gelu_t(a[1]); s[2] = gelu_t(a[2]); s[3] = gelu_t(a[3]); return s; }
struct F1 {
    bf16_t *q, *k, *v, *g, *sA, *sB, *xl, *gg; float* flow;
    __device__ __forceinline__ void operator()(int row, int col, f32x4 a, f32x4 b, int cu) const {
        if (cu < 3072) {
            bf16_t* base; int ld, c;
            if (cu < 512) { base = q; ld = 512; c = col; } else if (cu < 1024) { base = k; ld = 512; c = col - 512; } else if (cu < 2048) { base = v; ld = 1024; c = col - 1024; } else { base = g; ld = 1024; c = col - 2048; }
            st8(base + (size_t)row * ld + c, a, b);
        } else if (cu < 5120) {
            if (cu < 4096) st8(sA + (size_t)row * DM + (col - 3072), sigm4(a), sigm4(b)); else st8(sB + (size_t)row * DM + (col - 4096), sigm4(a), sigm4(b));
        } else if (cu < 6464) { st8(xl + (size_t)row * LW + (col - 5120), a, b);
        } else if (cu < 7808) { st8(gg + (size_t)row * LW + (col - 6464), gelu4(a), gelu4(b));
        } else if (col < 7824) { float* p = flow + (size_t)row * 16 + (col - 7808); *(f32x4*)p = a; *(f32x4*)(p + 4) = b; }
    }
};
struct F2 {
    const bf16_t* sA; bf16_t* yas;
    __device__ __forceinline__ void operator()(int row, int col, f32x4 a, f32x4 b, int) const { const size_t o = (size_t)row * DM + col; f32x4 s0, s1; ld8(sA + o, s0, s1); st8(yas + o, s0 * a, s1 * b); }
};
struct F3 {
    const bf16_t *sB, *yas; bf16_t* merged;
    __device__ __forceinline__ void operator()(int row, int col, f32x4 a, f32x4 b, int) const { const size_t o = (size_t)row * DM + col; f32x4 s0, s1, y0, y1; ld8(sB + o, s0, s1); ld8(yas + o, y0, y1); st8(merged + o, y0 + s0 * a, y1 + s1 * b); }
};
constexpr int X1B_ROWS = 65 * 254 + 2;
struct E4 {
    static constexpr bool PERM = true, AFTER_DRAIN = false, APERM = false, HAS_INIT = true;
    const float* x; float* x1; bf16_t* x1b; float* rowsq;
    __device__ __forceinline__ void init(f32x4 (&acc)[2][2][4][2], const pg8::Unit& u, int wr, int wc, int fr, int fq) const {
#pragma unroll
        for (int ai = 0; ai < 2; ++ai)
#pragma unroll
            for (int m = 0; m < 4; ++m)
#pragma unroll
                for (int bj = 0; bj < 2; ++bj) { const float* p = x + (size_t)(u.pm * 256 + ai * 128 + wr * 64 + m * 16 + fr) * DM + u.pn * 256 + bj * 128 + wc * 32 + 8 * fq; acc[ai][bj][m][0] = *(const f32x4*)p; acc[ai][bj][m][1] = *(const f32x4*)(p + 4); }
    }
    __device__ __forceinline__ void operator()(f32x4 (&acc)[2][2][4][2], const pg8::Unit& u, int wr, int wc, int fr, int fq) const {
#pragma unroll
        for (int ai = 0; ai < 2; ++ai)
#pragma unroll
            for (int m = 0; m < 4; ++m) { const int row = u.pm * 256 + ai * 128 + wr * 64 + m * 16 + fr; float ss = 0.f;
#pragma unroll
                for (int bj = 0; bj < 2; ++bj) { const size_t o = (size_t)row * DM + u.pn * 256 + bj * 128 + wc * 32 + 8 * fq;
                    const f32x4 r0 = acc[ai][bj][m][0], r1 = acc[ai][bj][m][1];
                    st8(x1b + o + 2 * DM, r0, r1);
                    ss += r0[0] * r0[0] + r0[1] * r0[1] + r0[2] * r0[2] + r0[3] * r0[3] + r1[0] * r1[0] + r1[1] * r1[1] + r1[2] * r1[2] + r1[3] * r1[3]; }
                ss += __shfl_xor(ss, 16); ss += __shfl_xor(ss, 32);
                if (fq == 0) atomicAdd(rowsq + row, ss); }
    }
};
struct E6 {
    static constexpr bool PERM = true, AFTER_DRAIN = false, APERM = false, HAS_INIT = true;
    float* xo; const bf16_t* x1b;
    __device__ __forceinline__ void init(f32x4 (&acc)[2][2][4][2], const pg8::Unit& u, int wr, int wc, int fr, int fq) const {
#pragma unroll
        for (int ai = 0; ai < 2; ++ai)
#pragma unroll
            for (int m = 0; m < 4; ++m)
#pragma unroll
                for (int bj = 0; bj < 2; ++bj) { const bf16_t* p = x1b + (size_t)(2 + u.pm * 256 + ai * 128 + wr * 64 + m * 16 + fr) * DM + u.pn * 256 + bj * 128 + wc * 32 + 8 * fq; ld8(p, acc[ai][bj][m][0], acc[ai][bj][m][1]); }
    }
    __device__ __forceinline__ void operator()(f32x4 (&acc)[2][2][4][2], const pg8::Unit& u, int wr, int wc, int fr, int fq) const {
#pragma unroll
        for (int ai = 0; ai < 2; ++ai)
#pragma unroll
            for (int m = 0; m < 4; ++m)
#pragma unroll
                for (int bj = 0; bj < 2; ++bj) { float* p = xo + (size_t)(u.pm * 256 + ai * 128 + wr * 64 + m * 16 + fr) * DM + u.pn * 256 + bj * 128 + wc * 32 + 8 * fq; *(f32x4*)p = acc[ai][bj][m][0]; *(f32x4*)(p + 4) = acc[ai][bj][m][1]; }
    }
};
constexpr int XCH_OFF = 131072;
struct E5f {
    static constexpr bool PERM = true, AFTER_DRAIN = false, APERM = true, HAS_INIT = false;
    const float* rowsq; const float* cw; const float* cb; bf16_t* act; PG8_LAS float* X;
    __device__ __forceinline__ static f32x4 rot(f32x4 v, int) { f32x4 r;
#pragma unroll
        for (int j = 0; j < 4; ++j) r[j] = __int_as_float(__builtin_amdgcn_update_dpp(0, __float_as_int(v[j]), 0x111, 0xf, 0xf, false));
        return r; }
    __device__ __forceinline__ void operator()(f32x4 (&acc)[2][2][4][2], const pg8::Unit& u, int wr, int wc, int fr_, int fq_) const {
        int fr = fr_, fq = fq_; asm volatile("" : "+v"(fr), "+v"(fq));
        const int lane = fq * 16 + fr;
#pragma unroll
        for (int ai = 0; ai < 2; ++ai)
#pragma unroll
            for (int m = 0; m < 4; ++m) { int gr = 254 * u.pm + ai * 128 + wr * 64 + 4 * fr + m - 2; gr = gr < 0 ? 0 : (gr > SEQ - 1 ? SEQ - 1 : gr);
                const float r = rsqrtf(rowsq[gr] * (1.0f / DM) + 1e-6f);
#pragma unroll
                for (int bj = 0; bj < 2; ++bj) { acc[ai][bj][m][0] = acc[ai][bj][m][0] * r; acc[ai][bj][m][1] = acc[ai][bj][m][1] * r; }
                asm volatile("" : "+v"(acc[ai][0][m][0]), "+v"(acc[ai][0][m][1]), "+v"(acc[ai][1][m][0]), "+v"(acc[ai][1][m][1])); }
#pragma unroll
        for (int ai = 0; ai < 2; ++ai) { const int slot = 2 * ai + wr;
            if (slot < 3 && fr == 15) {
#pragma unroll
                for (int bj = 0; bj < 2; ++bj)
#pragma unroll
                    for (int rs = 0; rs < 2; ++rs) { PG8_LAS float* xp = X + ((((slot * 2 + rs) * 2 + bj) * 4 + wc) * 4 + fq) * 8; *(PG8_LAS f32x4*)xp = acc[ai][bj][2 + rs][0]; *(PG8_LAS f32x4*)(xp + 4) = acc[ai][bj][2 + rs][1]; } } }
        asm volatile("s_waitcnt lgkmcnt(0)" ::: "memory"); __builtin_amdgcn_s_barrier(); asm volatile("" ::: "memory");
        __builtin_amdgcn_s_barrier(); asm volatile("" ::: "memory");
        const int ch0 = 128 * u.pn + 32 * wc + 8 * fq; const int s1 = (lane & 48) | ((fr - 1) & 15); const bool f0 = fr == 0;
#pragma unroll
        for (int bj = 0; bj < 2; ++bj) {
#pragma unroll
            for (int n = 0; n < 2; ++n) {
                const float* wp = cw + bj * DFF + ch0 + 4 * n;
                const f32x4 w0 = *(const f32x4*)wp, w1 = *(const f32x4*)(wp + 2 * DFF), w2 = *(const f32x4*)(wp + 4 * DFF), bb = *(const f32x4*)(cb + bj * DFF + ch0 + 4 * n);
#pragma unroll
                for (int ai = 0; ai < 2; ++ai) {
                    const int slot = 2 * ai + wr - 1; f32x4 bm1 = {0.f, 0.f, 0.f, 0.f}, bm2 = {0.f, 0.f, 0.f, 0.f};
                    if (slot >= 0) { bm2 = *(const PG8_LAS f32x4*)(X + ((((slot * 2 + 0) * 2 + bj) * 4 + wc) * 4 + fq) * 8 + 4 * n); bm1 = *(const PG8_LAS f32x4*)(X + ((((slot * 2 + 1) * 2 + bj) * 4 + wc) * 4 + fq) * 8 + 4 * n); }
                    const f32x4 x0 = acc[ai][bj][0][n], x1v = acc[ai][bj][1][n], x2v = acc[ai][bj][2][n], x3v = acc[ai][bj][3][n];
                    const f32x4 r3 = rot(x3v, s1), r2 = rot(x2v, s1);
                    f32x4 o0, o1, o2, o3;
#pragma unroll
                    for (int j = 0; j < 4; ++j) {
                        const float p1 = f0 ? bm1[j] : r3[j], p2 = f0 ? bm2[j] : r2[j];
                        o0[j] = bb[j] + w2[j] * x0[j] + w1[j] * p1 + w0[j] * p2;
                        o1[j] = bb[j] + w2[j] * x1v[j] + w1[j] * x0[j] + w0[j] * p1;
                        o2[j] = bb[j] + w2[j] * x2v[j] + w1[j] * x1v[j] + w0[j] * x0[j];
                        o3[j] = bb[j] + w2[j] * x3v[j] + w1[j] * x2v[j] + w0[j] * x1v[j];
                    }
                    acc[ai][bj][0][n] = o0; acc[ai][bj][1][n] = o1; acc[ai][bj][2][n] = o2; acc[ai][bj][3][n] = o3;
                    asm volatile("" : "+v"(acc[ai][bj][0][n]), "+v"(acc[ai][bj][1][n]), "+v"(acc[ai][bj][2][n]), "+v"(acc[ai][bj][3][n]));
                    __builtin_amdgcn_sched_barrier(0);
                }
                asm volatile("" ::: "memory");
            }
        }
#pragma unroll
        for (int ai = 0; ai < 2; ++ai)
#pragma unroll
            for (int m = 0; m < 4; ++m) { const int lr = ai * 128 + wr * 64 + 4 * fr + m, gr = 254 * u.pm + lr - 2;
                if (lr >= 2 && gr < SEQ) st8(act + (size_t)gr * DFF + ch0, gelu4(acc[ai][0][m][0]) * acc[ai][1][m][0], gelu4(acc[ai][0][m][1]) * acc[ai][1][m][1]); }
    }
};
struct F6 {
    float* x1;
    __device__ __forceinline__ void operator()(int row, int col, f32x4 a, f32x4 b, int) const { float* p = x1 + (size_t)row * DM + col; *(f32x4*)p = *(const f32x4*)p + a; *(f32x4*)(p + 4) = *(const f32x4*)(p + 4) + b; }
};

#ifdef NAIVE_GLA
__device__ void gla_naive(const Params& P, float* sm) {
    if (blockIdx.x >= 4) return;
    const int h = blockIdx.x, tid = threadIdx.x;
    const bf16_t* q = (const bf16_t*)(P.ws + WS_Q); const bf16_t* k = (const bf16_t*)(P.ws + WS_K); const bf16_t* v = (const bf16_t*)(P.ws + WS_V); bf16_t* g = (bf16_t*)(P.ws + WS_G);
    const float* flow = (const float*)(P.ws + WS_FLOW); const float* wf2 = P.in[3]; const float* bf2 = P.in[4]; const float* onorm = P.in[5];
    float* al = sm; float* qs = sm + 128; float* ks = sm + 256; float* red = sm + 384;
    float St[128];
#pragma unroll
    for (int i = 0; i < 128; ++i) St[i] = 0.f;
    float wcol[16]; float bcol = 0.f;
    if (tid < 128) {
#pragma unroll
        for (int r = 0; r < 16; ++r) wcol[r] = wf2[r * 512 + h * 128 + tid];
        bcol = bf2[h * 128 + tid];
    } else {
#pragma unroll
        for (int r = 0; r < 16; ++r) wcol[r] = 0.f;
    }
    const float on = tid < 256 ? onorm[tid] : 0.f;
    for (int t = 0; t < SEQ; ++t) {
        if (tid < 128) {
            float z = bcol;
#pragma unroll
            for (int r = 0; r < 16; ++r) z += flow[(size_t)t * 16 + r] * wcol[r];
            const float ls = fminf(z, 0.f) - log1pf(__expf(-fabsf(z)));
            al[tid] = __expf(ls * (1.0f / 16.0f));
            qs[tid] = bf2f(q[(size_t)t * 512 + h * 128 + tid]) * 0.08838834764831845f;
            ks[tid] = bf2f(k[(size_t)t * 512 + h * 128 + tid]);
        }
        __syncthreads();
        float o = 0.f;
        if (tid < 256) {
            const float vv = bf2f(v[(size_t)t * 1024 + h * 256 + tid]);
#pragma unroll
            for (int i = 0; i < 128; ++i) { St[i] = al[i] * St[i] + ks[i] * vv; o += qs[i] * St[i]; }
        }
        const float s2 = wave_sum(o * o);
        if ((tid & 63) == 0) red[tid >> 6] = s2;
        __syncthreads();
        if (tid < 256) {
            const float tot = red[0] + red[1] + red[2] + red[3];
            const float rr = rsqrtf(tot * (1.0f / 256.0f) + 1e-6f);
            const size_t gi = (size_t)t * 1024 + h * 256 + tid;
            const float gv = bf2f(g[gi]);
            const float res = o * rr * on * (gv * sigm(gv));
            g[gi] = (bf16_t)(pg8::cvt_pk_bf16(res, 0.f) & 0xffffu);
        }
    }
}
#endif
#ifdef NAIVE_LRU
__device__ void lru_naive(const Params& P, float* sm) {
    if (blockIdx.x >= 8) return;
    const int j = blockIdx.x, tid = threadIdx.x; const bool act = tid < 168; const int ch = j * 168 + (act ? tid : 0);
    const bf16_t* xl = (const bf16_t*)(P.ws + WS_XL); const bf16_t* gg = (const bf16_t*)(P.ws + WS_GG); bf16_t* hb = (bf16_t*)(P.ws + WS_HB);
    const float* cw = P.in[7]; const float* cb = P.in[8]; const float* wa = P.in[9] + (size_t)j * 168 * 168; const float* ba = P.in[10]; const float* wx = P.in[11] + (size_t)j * 168 * 168; const float* bx = P.in[12]; const float* ap = P.in[13];
    const float w0 = cw[ch], w1 = cw[LW + ch], w2 = cw[2 * LW + ch], w3 = cw[3 * LW + ch], b0 = cb[ch], bav = ba[ch], bxv = bx[ch];
    const float apv = ap[ch]; const float sp = fmaxf(apv, 0.f) + log1pf(__expf(-fabsf(apv)));
    float x3 = 0.f, x2 = 0.f, x1 = 0.f, hs = 0.f;
    float* xcs = sm;
    for (int t = 0; t < SEQ; ++t) {
        float xc = 0.f;
        if (act) { const float xv = bf2f(xl[(size_t)t * LW + ch]); xc = b0 + w0 * x3 + w1 * x2 + w2 * x1 + w3 * xv; x3 = x2; x2 = x1; x1 = xv; xcs[tid] = xc; }
        __syncthreads();
        if (act) {
            float ra = bav, ri = bxv;
            for (int c = 0; c < 168; ++c) { const float xv = xcs[c]; ra += xv * wa[c * 168 + tid]; ri += xv * wx[c * 168 + tid]; }
            const float r = sigm(ra), ig = sigm(ri);
            const float la = -8.0f * r * sp; const float a = __expf(la);
            const float uu = sqrtf(-expm1f(2.0f * la)) * (ig * xc);
            hs = a * hs + uu;
            const float res = hs * bf2f(gg[(size_t)t * LW + ch]);
            hb[(size_t)t * LWP + ch] = (bf16_t)(pg8::cvt_pk_bf16(res, 0.f) & 0xffffu);
        } else if (tid < 176) { hb[(size_t)t * LWP + LW + j * 8 + (tid - 168)] = 0; }
        __syncthreads();
    }
}
#endif
typedef pg8::bf16x8 bf16x8;
typedef unsigned u32x4_t __attribute__((ext_vector_type(4)));
typedef unsigned u32x2_t __attribute__((ext_vector_type(2)));
#define LAS PG8_LAS
constexpr int GL_QS = 0, GL_KT = 17408, GL_KST = 34816, GL_VT = 53248, GL_AM = 90112, GL_DEC = 99328, GL_RSQ = 99840, GL_WF = 101888, GL_BF = 110080;
constexpr int RS128 = 272, RS64 = 144;
constexpr size_t WS_GATEW = 24 * MiB + 768 * 1024;
constexpr size_t WS_DSEG = 25 * MiB + 896 * 1024;
constexpr size_t OUT_L = 0;
constexpr size_t OUT_SUMS = 0;
constexpr size_t OUT_CARRY = 4 * MiB;

__device__ __forceinline__ unsigned short f2bf(float x) { return (unsigned short)(pg8::cvt_pk_bf16(x, 0.f) & 0xffffu); }
__device__ __forceinline__ bf16x8 pack8(f32x4 a, f32x4 b) { u32x4_t w; w[0] = pg8::cvt_pk_bf16(a[0], a[1]); w[1] = pg8::cvt_pk_bf16(a[2], a[3]); w[2] = pg8::cvt_pk_bf16(b[0], b[1]); w[3] = pg8::cvt_pk_bf16(b[2], b[3]); return __builtin_bit_cast(bf16x8, w); }
#define MFMA16(a, b, c) __builtin_amdgcn_mfma_f32_16x16x32_bf16((a), (b), (c), 0, 0, 0)

template <bool OUT>
__device__ void gla_pass(const Params& P, LAS unsigned char* lds) {
    const int tid = threadIdx.x, lane = tid & 63, w = __builtin_amdgcn_readfirstlane(tid >> 6), fr = lane & 15, fq = lane >> 4;
    const bf16_t* q = (const bf16_t*)(P.ws + WS_Q); const bf16_t* k = (const bf16_t*)(P.ws + WS_K); const bf16_t* v = (const bf16_t*)(P.ws + WS_V); bf16_t* g = (bf16_t*)(P.ws + WS_G);
    const float* flow = (const float*)(P.ws + WS_FLOW); const float* wf2 = P.in[3]; const float* bf2 = P.in[4]; const float* onorm = P.in[5];
    float* L = (float*)((unsigned char*)P.out + OUT_L); float* Dg = (float*)(P.ws + WS_DSEG);
    LAS float* dec = (LAS float*)(lds + GL_DEC); LAS float* rsq = (LAS float*)(lds + GL_RSQ);
    for (int item = blockIdx.x; item < 256; item += gridDim.x) {
        const int s = item >> 2, h = item & 3;
        f32x4 Sa[8][2];
        float* Lp = L + (size_t)(s * 4 + h) * 32768 + w * 4096;
#pragma unroll
        for (int mt = 0; mt < 8; ++mt)
#pragma unroll
            for (int ni = 0; ni < 2; ++ni) Sa[mt][ni] = OUT ? *(const f32x4*)(Lp + ((mt * 2 + ni) * 64 + lane) * 4) : (f32x4){0.f, 0.f, 0.f, 0.f};
        float blsum[16];
#pragma unroll
        for (int i = 0; i < 16; ++i) blsum[i] = 0.f;
        for (int e = tid; e < 2048; e += 512) { const int r = e >> 7, kc = e & 127; *(LAS float*)(lds + GL_WF + (kc * 16 + r) * 4) = wf2[r * 512 + h * 128 + kc]; }
        if (tid < 128) *(LAS float*)(lds + GL_BF + tid * 4) = bf2[h * 128 + tid];
        __syncthreads();
        f32x4 flp[4]; uint4 qap, qbp, kap, kbp;
        if constexpr (!OUT) { const size_t tp = (size_t)(s * 256 + lane);
#pragma unroll
          for (int r4 = 0; r4 < 4; ++r4) flp[r4] = *(const f32x4*)(flow + tp * 16 + r4 * 4);
          qap = *(const uint4*)(q + tp * 512 + h * 128 + 16 * w); qbp = *(const uint4*)(q + tp * 512 + h * 128 + 16 * w + 8);
          kap = *(const uint4*)(k + tp * 512 + h * 128 + 16 * w); kbp = *(const uint4*)(k + tp * 512 + h * 128 + 16 * w + 8); }
        for (int ch = 0; ch < 4; ++ch) {
            const int t0 = s * 256 + ch * 64; const size_t t = (size_t)(t0 + lane);
            uint4 vpre[4];
#pragma unroll
            for (int i = 0; i < 4; ++i) vpre[i] = *(const uint4*)(v + t * 1024 + h * 256 + 8 * (w + 8 * i));
            uint2 gpre[4][2];
            if (OUT) {
#pragma unroll
                for (int nt = 0; nt < 4; ++nt)
#pragma unroll
                    for (int mi = 0; mi < 2; ++mi) gpre[nt][mi] = *(const uint2*)(g + (size_t)(t0 + 16 * nt + fr) * 1024 + h * 256 + 16 * (2 * w + mi) + 4 * fq);
            }
            {
                float fl[16]; uint4 qa, qb, ka, kb;
                if constexpr (OUT) {
#pragma unroll
                    for (int r4 = 0; r4 < 4; ++r4) { const f32x4 x = *(const f32x4*)(flow + t * 16 + r4 * 4); fl[r4 * 4] = x[0]; fl[r4 * 4 + 1] = x[1]; fl[r4 * 4 + 2] = x[2]; fl[r4 * 4 + 3] = x[3]; }
                    qa = *(const uint4*)(q + t * 512 + h * 128 + 16 * w); qb = *(const uint4*)(q + t * 512 + h * 128 + 16 * w + 8);
                    ka = *(const uint4*)(k + t * 512 + h * 128 + 16 * w); kb = *(const uint4*)(k + t * 512 + h * 128 + 16 * w + 8);
                } else {
#pragma unroll
                    for (int r4 = 0; r4 < 4; ++r4) { const f32x4 x = flp[r4]; fl[r4 * 4] = x[0]; fl[r4 * 4 + 1] = x[1]; fl[r4 * 4 + 2] = x[2]; fl[r4 * 4 + 3] = x[3]; }
                    qa = qap; qb = qbp; ka = kap; kb = kbp;
                    if (ch < 3) { const size_t tn = t + 64;
#pragma unroll
                        for (int r4 = 0; r4 < 4; ++r4) flp[r4] = *(const f32x4*)(flow + tn * 16 + r4 * 4);
                        qap = *(const uint4*)(q + tn * 512 + h * 128 + 16 * w); qbp = *(const uint4*)(q + tn * 512 + h * 128 + 16 * w + 8);
                        kap = *(const uint4*)(k + tn * 512 + h * 128 + 16 * w); kbp = *(const uint4*)(k + tn * 512 + h * 128 + 16 * w + 8); }
                }
                const unsigned qw[8] = {qa.x, qa.y, qa.z, qa.w, qb.x, qb.y, qb.z, qb.w}, kw[8] = {ka.x, ka.y, ka.z, ka.w, kb.x, kb.y, kb.z, kb.w};
                float qt[16], kt[16];
#pragma unroll
                for (int i = 0; i < 16; ++i) {
                    float z = *(const LAS float*)(lds + GL_BF + (16 * w + i) * 4);
#pragma unroll
                    for (int r4 = 0; r4 < 4; ++r4) { const f32x4 wv = *(const LAS f32x4*)(lds + GL_WF + ((16 * w + i) * 16 + r4 * 4) * 4); z += fl[r4 * 4] * wv[0] + fl[r4 * 4 + 1] * wv[1] + fl[r4 * 4 + 2] * wv[2] + fl[r4 * 4 + 3] * wv[3]; }
                    float b = (fminf(z, 0.f) - __logf(1.0f + __expf(-fabsf(z)))) * (1.0f / 16.0f);
                    b += __int_as_float(__builtin_amdgcn_update_dpp(0, __float_as_int(b), 0x111, 0xf, 0xf, false));
                    b += __int_as_float(__builtin_amdgcn_update_dpp(0, __float_as_int(b), 0x112, 0xf, 0xf, false));
                    b += __int_as_float(__builtin_amdgcn_update_dpp(0, __float_as_int(b), 0x114, 0xf, 0xf, false));
                    b += __int_as_float(__builtin_amdgcn_update_dpp(0, __float_as_int(b), 0x118, 0xf, 0xf, false));
                    { const float t0r = __int_as_float(__builtin_amdgcn_readlane(__float_as_int(b), 15)), t1r = __int_as_float(__builtin_amdgcn_readlane(__float_as_int(b), 31)), t2r = __int_as_float(__builtin_amdgcn_readlane(__float_as_int(b), 47));
                      b += fq == 0 ? 0.f : (fq == 1 ? t0r : (fq == 2 ? t0r + t1r : t0r + t1r + t2r)); }
                    const float bl = __int_as_float(__builtin_amdgcn_readlane(__float_as_int(b), 63));
                    const float qv = (i & 1) ? __uint_as_float(qw[i >> 1] & 0xffff0000u) : __uint_as_float(qw[i >> 1] << 16);
                    const float kv = (i & 1) ? __uint_as_float(kw[i >> 1] & 0xffff0000u) : __uint_as_float(kw[i >> 1] << 16);
                    qt[i] = qv * __expf(b) * 0.08838834764831845f; kt[i] = kv * __expf(-b);
                    *(LAS unsigned short*)(lds + GL_KST + (16 * w + i) * RS64 + lane * 2) = f2bf(kv * __expf(bl - b));
                    if (lane == 63) dec[16 * w + i] = __expf(bl);
                    blsum[i] += bl;
                }
                u32x4_t p0, p1;
#pragma unroll
                for (int i = 0; i < 4; ++i) { p0[i] = pg8::cvt_pk_bf16(qt[2 * i], qt[2 * i + 1]); p1[i] = pg8::cvt_pk_bf16(qt[8 + 2 * i], qt[8 + 2 * i + 1]); }
                *(LAS u32x4_t*)(lds + GL_QS + lane * RS128 + 32 * w) = p0; *(LAS u32x4_t*)(lds + GL_QS + lane * RS128 + 32 * w + 16) = p1;
#pragma unroll
                for (int i = 0; i < 4; ++i) { p0[i] = pg8::cvt_pk_bf16(kt[2 * i], kt[2 * i + 1]); p1[i] = pg8::cvt_pk_bf16(kt[8 + 2 * i], kt[8 + 2 * i + 1]); }
                *(LAS u32x4_t*)(lds + GL_KT + lane * RS128 + 32 * w) = p0; *(LAS u32x4_t*)(lds + GL_KT + lane * RS128 + 32 * w + 16) = p1;
            }
#pragma unroll
            for (int i = 0; i < 4; ++i) {
                const int cgp = w + 8 * i; const uint4 vv = vpre[i]; const unsigned vw[4] = {vv.x, vv.y, vv.z, vv.w};
#pragma unroll
                for (int e = 0; e < 8; ++e) *(LAS unsigned short*)(lds + GL_VT + (8 * cgp + e) * RS64 + lane * 2) = (unsigned short)((e & 1) ? (vw[e >> 1] >> 16) : (vw[e >> 1] & 0xffffu));
            }
            __syncthreads();
            if (OUT) {
                {
                    const int nt = w & 3;
#pragma unroll
                    for (int mm = 0; mm < 2; ++mm) {
                        const int mt = 2 * (w >> 2) + mm; f32x4 acc = {0.f, 0.f, 0.f, 0.f};
                        if (mt <= nt) {
#pragma unroll
                            for (int kk = 0; kk < 4; ++kk) { const bf16x8 a = *(const LAS bf16x8*)(lds + GL_KT + (16 * mt + fr) * RS128 + (32 * kk + 8 * fq) * 2); const bf16x8 b = *(const LAS bf16x8*)(lds + GL_QS + (16 * nt + fr) * RS128 + (32 * kk + 8 * fq) * 2); acc = MFMA16(a, b, acc); }
                        }
#pragma unroll
                        for (int j = 0; j < 4; ++j) if (16 * mt + 4 * fq + j > 16 * nt + fr) acc[j] = 0.f;
                        u32x2_t pw; pw[0] = pg8::cvt_pk_bf16(acc[0], acc[1]); pw[1] = pg8::cvt_pk_bf16(acc[2], acc[3]);
                        *(LAS u32x2_t*)(lds + GL_AM + (16 * nt + fr) * RS64 + (16 * mt + 4 * fq) * 2) = pw;
                    }
                }
                __syncthreads();
                f32x4 oT[2][4];
#pragma unroll
                for (int mi = 0; mi < 2; ++mi)
#pragma unroll
                    for (int nt = 0; nt < 4; ++nt) oT[mi][nt] = (f32x4){0.f, 0.f, 0.f, 0.f};
#pragma unroll
                for (int kk = 0; kk < 2; ++kk) {
                    bf16x8 bfr[4];
#pragma unroll
                    for (int nt = 0; nt < 4; ++nt) bfr[nt] = *(const LAS bf16x8*)(lds + GL_AM + (16 * nt + fr) * RS64 + (32 * kk + 8 * fq) * 2);
#pragma unroll
                    for (int mi = 0; mi < 2; ++mi) { const bf16x8 a = *(const LAS bf16x8*)(lds + GL_VT + (16 * (2 * w + mi) + fr) * RS64 + (32 * kk + 8 * fq) * 2);
#pragma unroll
                        for (int nt = 0; nt < 4; ++nt) oT[mi][nt] = MFMA16(a, bfr[nt], oT[mi][nt]); }
                }
#pragma unroll
                for (int kk = 0; kk < 4; ++kk) {
                    bf16x8 bfr[4];
#pragma unroll
                    for (int nt = 0; nt < 4; ++nt) { const u32x2_t lo = *(const LAS u32x2_t*)(lds + GL_QS + (16 * nt + fr) * RS128 + (32 * kk + 4 * fq) * 2), hi = *(const LAS u32x2_t*)(lds + GL_QS + (16 * nt + fr) * RS128 + (32 * kk + 16 + 4 * fq) * 2);
                        u32x4_t wv; wv[0] = lo[0]; wv[1] = lo[1]; wv[2] = hi[0]; wv[3] = hi[1]; bfr[nt] = __builtin_bit_cast(bf16x8, wv); }
#pragma unroll
                    for (int mi = 0; mi < 2; ++mi) { const bf16x8 a = pack8(Sa[2 * kk][mi], Sa[2 * kk + 1][mi]);
#pragma unroll
                        for (int nt = 0; nt < 4; ++nt) oT[mi][nt] = MFMA16(a, bfr[nt], oT[mi][nt]); }
                }
#pragma unroll
                for (int nt = 0; nt < 4; ++nt) {
                    float ps = 0.f;
#pragma unroll
                    for (int mi = 0; mi < 2; ++mi)
#pragma unroll
                        for (int j = 0; j < 4; ++j) ps += oT[mi][nt][j] * oT[mi][nt][j];
                    ps += __shfl_xor(ps, 16); ps += __shfl_xor(ps, 32);
                    if (fq == 0) rsq[(16 * nt + fr) * 8 + w] = ps;
                }
                __syncthreads();
#pragma unroll
                for (int nt = 0; nt < 4; ++nt) {
                    const f32x4 r0 = *(const LAS f32x4*)(rsq + (16 * nt + fr) * 8), r1 = *(const LAS f32x4*)(rsq + (16 * nt + fr) * 8 + 4);
                    const float tot = (r0[0] + r0[1]) + (r0[2] + r0[3]) + (r1[0] + r1[1]) + (r1[2] + r1[3]);
                    const float rstd = rsqrtf(tot * (1.0f / 256.0f) + 1e-6f);
#pragma unroll
                    for (int mi = 0; mi < 2; ++mi) {
                        const int c = 16 * (2 * w + mi) + 4 * fq; const size_t gi = (size_t)(t0 + 16 * nt + fr) * 1024 + h * 256 + c;
                        f32x4 gv; { const uint2 gw2 = gpre[nt][mi]; gv[0] = __uint_as_float(gw2.x << 16); gv[1] = __uint_as_float(gw2.x & 0xffff0000u); gv[2] = __uint_as_float(gw2.y << 16); gv[3] = __uint_as_float(gw2.y & 0xffff0000u); }
                        const f32x4 on = *(const f32x4*)(onorm + c); f32x4 res;
#pragma unroll
                        for (int j = 0; j < 4; ++j) res[j] = oT[mi][nt][j] * rstd * on[j] * (gv[j] * sigm(gv[j]));
                        st4(g + gi, res);
                    }
                }
            }
#pragma unroll
            for (int mt = 0; mt < 8; ++mt) { const f32x4 dv = *(const LAS f32x4*)(dec + 16 * mt + 4 * fq);
#pragma unroll
                for (int ni = 0; ni < 2; ++ni) Sa[mt][ni] = Sa[mt][ni] * dv; }
#pragma unroll
            for (int kk = 0; kk < 2; ++kk) {
                bf16x8 bfr[2];
#pragma unroll
                for (int ni = 0; ni < 2; ++ni) bfr[ni] = *(const LAS bf16x8*)(lds + GL_VT + (16 * (2 * w + ni) + fr) * RS64 + (32 * kk + 8 * fq) * 2);
#pragma unroll
                for (int mt = 0; mt < 8; ++mt) { const bf16x8 a = *(const LAS bf16x8*)(lds + GL_KST + (16 * mt + fr) * RS64 + (32 * kk + 8 * fq) * 2);
#pragma unroll
                    for (int ni = 0; ni < 2; ++ni) Sa[mt][ni] = MFMA16(a, bfr[ni], Sa[mt][ni]); }
            }
            __syncthreads();
        }
        if (!OUT) {
#pragma unroll
            for (int mt = 0; mt < 8; ++mt)
#pragma unroll
                for (int ni = 0; ni < 2; ++ni) *(f32x4*)(Lp + ((mt * 2 + ni) * 64 + lane) * 4) = Sa[mt][ni];
            if (lane == 0) {
#pragma unroll
                for (int i = 0; i < 16; ++i) Dg[(s * 4 + h) * 128 + 16 * w + i] = __expf(blsum[i]);
            }
        }
    }
}
__device__ void gla_scan(const Params& P) {
    float* L = (float*)((unsigned char*)P.out + OUT_L); const float* Dg = (const float*)(P.ws + WS_DSEG);
    for (int e = blockIdx.x * 512 + threadIdx.x; e < 131072; e += gridDim.x * 512) {
        const int h = e >> 15, r = e & 32767, mt = (r >> 9) & 7, ln = (r >> 2) & 63, j = r & 3; const int kk = 16 * mt + 4 * (ln >> 4) + j;
        float st = 0.f;
        for (int s0 = 0; s0 < 64; s0 += 32) {
            float tmp[32], dd[32];
#pragma unroll
            for (int i = 0; i < 32; ++i) { tmp[i] = L[(size_t)((s0 + i) * 4 + h) * 32768 + r]; dd[i] = Dg[((s0 + i) * 4 + h) * 128 + kk]; }
#pragma unroll
            for (int i = 0; i < 32; ++i) { L[(size_t)((s0 + i) * 4 + h) * 32768 + r] = st; st = dd[i] * st + tmp[i]; }
        }
    }
}

constexpr int LR_XCB = 0, LR_XCF = 25600, LR_AA = 71680, LR_PE = 117760, LR_CW = 121792, LR_XN = 127488;
constexpr int XCB_RS = 400, XCF_RS = 720;
constexpr size_t WS_SP = 255 * MiB + 64 * 1024;
__device__ void lru_pass1(const Params& P, LAS unsigned char* lds) {
    const int tid = threadIdx.x, lane = tid & 63, w = __builtin_amdgcn_readfirstlane(tid >> 6), fr = lane & 15, fq = lane >> 4;
    const bf16_t* xl = (const bf16_t*)(P.ws + WS_XL); bf16_t* gg = (bf16_t*)(P.ws + WS_GG); bf16_t* a1 = (bf16_t*)(P.ws + WS_HB);
    const bf16_t* gw = (const bf16_t*)(P.ws + WS_GATEW); float* sums = (float*)((unsigned char*)P.out + OUT_SUMS);
    const float* cw = P.in[7]; const float* cb = P.in[8]; const float* ba = P.in[10]; const float* bx = P.in[12]; const float* spp = (const float*)(P.ws + WS_SP);
    LAS float* CW = (LAS float*)(lds + LR_CW);
    int jb_lds = -1;
    auto dma_x = [&](int it_) {
        const int t0n = (it_ >> 3) * 64, jbn = it_ & 7;
#pragma unroll
        for (int i = 0; i < 3; ++i) {
            int p = (i * 8 + w) * 64 + lane; p = p < 67 * 21 ? p : 67 * 21 - 1;
            const int row = p / 21, c16 = p - row * 21; int tg = t0n - 3 + row; tg = tg < 0 ? 0 : tg;
            __builtin_amdgcn_global_load_lds((const unsigned*)(xl + (size_t)tg * LW + jbn * 168 + c16 * 8), (LAS unsigned*)(lds + LR_XN + (i * 8 + w) * 1024), 16, 0, 0);
        }
    };
    if ((int)blockIdx.x < 2048) dma_x((int)blockIdx.x);
    for (int item = blockIdx.x; item < 2048; item += gridDim.x) {
        const int tile = item >> 3, jb = item & 7, t0 = tile * 64;
        if (jb != jb_lds) {
            __syncthreads();
            for (int e = tid; e < 8 * 168; e += 512) { const int r = e / 168, c = e - r * 168, chn = jb * 168 + c;
                CW[r * 176 + c] = r < 4 ? cw[r * LW + chn] : (r == 4 ? cb[chn] : (r == 5 ? ba[chn] : (r == 6 ? bx[chn] : spp[chn]))); }
            jb_lds = jb;
            __syncthreads();
        }
        const bf16_t* waT = gw + (size_t)(jb * 2) * 192 * 192; const bf16_t* wxT = waT + 192 * 192;
        bf16x8 aA[6], aX[6];
        { const int m = w >> 1;
#pragma unroll
          for (int kk = 0; kk < 6; ++kk) { aA[kk] = *(const bf16x8*)(waT + (16 * m + fr) * 192 + 32 * kk + 8 * fq); aX[kk] = *(const bf16x8*)(wxT + (16 * m + fr) * 192 + 32 * kk + 8 * fq); } }
        uint4 ggpre[3];
#pragma unroll
        for (int it = 0; it < 3; ++it) { const int wi = tid + 512 * it; const int tt = wi / 21, c0 = (wi - tt * 21) * 8; ggpre[it] = wi < 64 * 21 ? *(const uint4*)(gg + (size_t)(t0 + tt) * LW + jb * 168 + c0) : make_uint4(0u, 0u, 0u, 0u); }
        asm volatile("s_waitcnt vmcnt(0)" ::: "memory"); __syncthreads();
        for (int wi = tid; wi < 64 * 24; wi += 512) {
            const int tt = wi / 24, cg8 = wi - tt * 24, c0 = cg8 * 8;
            if (cg8 < 21) {
                const int chn = jb * 168 + c0; f32x4 xa = *(const LAS f32x4*)(CW + 4 * 176 + c0), xb = *(const LAS f32x4*)(CW + 4 * 176 + c0 + 4);
#pragma unroll
                for (int d = 0; d < 4; ++d) {
                    const int tg = t0 + tt - 3 + d;
                    if (tg >= 0) { const u32x4_t xq = *(const LAS u32x4_t*)(lds + LR_XN + ((tt + d) * 21 + cg8) * 16); const uint4 xv = make_uint4(xq[0], xq[1], xq[2], xq[3]); const f32x4 wa4 = *(const LAS f32x4*)(CW + d * 176 + c0), wb4 = *(const LAS f32x4*)(CW + d * 176 + c0 + 4);
                        xa[0] += wa4[0] * __uint_as_float(xv.x << 16); xa[1] += wa4[1] * __uint_as_float(xv.x & 0xffff0000u); xa[2] += wa4[2] * __uint_as_float(xv.y << 16); xa[3] += wa4[3] * __uint_as_float(xv.y & 0xffff0000u);
                        xb[0] += wb4[0] * __uint_as_float(xv.z << 16); xb[1] += wb4[1] * __uint_as_float(xv.z & 0xffff0000u); xb[2] += wb4[2] * __uint_as_float(xv.w << 16); xb[3] += wb4[3] * __uint_as_float(xv.w & 0xffff0000u); }
                }
                u32x4_t pw; pw[0] = pg8::cvt_pk_bf16(xa[0], xa[1]); pw[1] = pg8::cvt_pk_bf16(xa[2], xa[3]); pw[2] = pg8::cvt_pk_bf16(xb[0], xb[1]); pw[3] = pg8::cvt_pk_bf16(xb[2], xb[3]);
                *(LAS u32x4_t*)(lds + LR_XCB + tt * XCB_RS + c0 * 2) = pw;
                *(LAS f32x4*)(lds + LR_XCF + tt * XCF_RS + c0 * 4) = xa; *(LAS f32x4*)(lds + LR_XCF + tt * XCF_RS + c0 * 4 + 16) = xb;
            } else { *(LAS u32x4_t*)(lds + LR_XCB + tt * XCB_RS + c0 * 2) = (u32x4_t){0u, 0u, 0u, 0u}; }
        }
        __syncthreads();
        if (item + (int)gridDim.x < 2048) dma_x(item + (int)gridDim.x);
        for (int un = w; un < 22; un += 8) {
            const int m = un >> 1, nh = un & 1; const int c0 = 16 * m + 4 * fq; const bool cv = c0 < 168; const int chn = jb * 168 + (cv ? c0 : 0);
            const int c0s = cv ? c0 : 0; const f32x4 bav = *(const LAS f32x4*)(CW + 5 * 176 + c0s), bxv = *(const LAS f32x4*)(CW + 6 * 176 + c0s), spv = *(const LAS f32x4*)(CW + 7 * 176 + c0s);
            f32x4 accA[2], accX[2];
#pragma unroll
            for (int nn = 0; nn < 2; ++nn) { accA[nn] = (f32x4){0.f, 0.f, 0.f, 0.f}; accX[nn] = accA[nn]; }
#pragma unroll
            for (int kk = 0; kk < 6; ++kk)
#pragma unroll
                for (int nn = 0; nn < 2; ++nn) { const bf16x8 bfr = *(const LAS bf16x8*)(lds + LR_XCB + (16 * (2 * nh + nn) + fr) * XCB_RS + (32 * kk + 8 * fq) * 2); accA[nn] = MFMA16(aA[kk], bfr, accA[nn]); accX[nn] = MFMA16(aX[kk], bfr, accX[nn]); }
            if (un + 8 < 22) { const int m2 = (un + 8) >> 1;
#pragma unroll
                for (int kk = 0; kk < 6; ++kk) { aA[kk] = *(const bf16x8*)(waT + (16 * m2 + fr) * 192 + 32 * kk + 8 * fq); aX[kk] = *(const bf16x8*)(wxT + (16 * m2 + fr) * 192 + 32 * kk + 8 * fq); } }
            if (cv) {
#pragma unroll
                for (int nn = 0; nn < 2; ++nn) {
                    const int tt = 16 * (2 * nh + nn) + fr; const f32x4 xcv = *(const LAS f32x4*)(lds + LR_XCF + tt * XCF_RS + c0 * 4); f32x4 av, uv;
#pragma unroll
                    for (int jj = 0; jj < 4; ++jj) {
                        const float r = __builtin_amdgcn_rcpf(1.0f + __expf(-(accA[nn][jj] + bav[jj]))), ig = __builtin_amdgcn_rcpf(1.0f + __expf(-(accX[nn][jj] + bxv[jj])));
                        const float a = __expf(-8.0f * r * spv[jj]); av[jj] = a; uv[jj] = sqrtf(fmaxf(1.0f - a * a, 0.f)) * (ig * xcv[jj]);
                    }
                    *(LAS f32x4*)(lds + LR_AA + tt * XCF_RS + c0 * 4) = av; *(LAS f32x4*)(lds + LR_XCF + tt * XCF_RS + c0 * 4) = uv;
                }
            }
        }
        __syncthreads();
        LAS float* PE = (LAS float*)(lds + LR_PE); LAS float* HE = PE + 3 * 168;
        if (tid < 504) {
            const int part = tid / 168, c = tid - part * 168, tb = part * 22, nst = part == 2 ? 20 : 22; float hs = 0.f, pp = 1.f;
            LAS unsigned char* pa0 = lds + LR_AA + tb * XCF_RS + c * 4; LAS unsigned char* pu0 = lds + LR_XCF + tb * XCF_RS + c * 4;
            float av[22], uv[22];
#pragma unroll
            for (int i = 0; i < 22; ++i) if (i < nst) { av[i] = *(const LAS float*)(pa0 + i * XCF_RS); uv[i] = *(const LAS float*)(pu0 + i * XCF_RS); }
#pragma unroll
            for (int i = 0; i < 22; ++i) if (i < nst) { hs = av[i] * hs + uv[i]; pp *= av[i]; uv[i] = hs; av[i] = pp; }
#pragma unroll
            for (int i = 0; i < 22; ++i) if (i < nst) { *(LAS float*)(pu0 + i * XCF_RS) = uv[i]; *(LAS float*)(pa0 + i * XCF_RS) = av[i]; }
            PE[tid] = pp; HE[tid] = hs;
        }
        __syncthreads();
#pragma unroll
        for (int it = 0; it < 3; ++it) {
            const int wi = tid + 512 * it; if (wi >= 64 * 21) break;
            const int tt = wi / 21, c0 = (wi - tt * 21) * 8; const int part = tt >= 44 ? 2 : (tt >= 22 ? 1 : 0);
            float hl[8], pl[8], chh[8], cpp[8];
            { const f32x4 x0 = *(const LAS f32x4*)(lds + LR_XCF + tt * XCF_RS + c0 * 4), x1 = *(const LAS f32x4*)(lds + LR_XCF + tt * XCF_RS + c0 * 4 + 16);
              const f32x4 y0 = *(const LAS f32x4*)(lds + LR_AA + tt * XCF_RS + c0 * 4), y1 = *(const LAS f32x4*)(lds + LR_AA + tt * XCF_RS + c0 * 4 + 16);
#pragma unroll
              for (int i = 0; i < 4; ++i) { hl[i] = x0[i]; hl[4 + i] = x1[i]; pl[i] = y0[i]; pl[4 + i] = y1[i]; } }
#pragma unroll
            for (int i = 0; i < 8; ++i) {
                const float p0 = PE[c0 + i], h0 = HE[c0 + i], p1 = PE[168 + c0 + i], h1v = HE[168 + c0 + i];
                chh[i] = part == 0 ? 0.f : (part == 1 ? h0 : p1 * h0 + h1v); cpp[i] = part == 0 ? 1.f : (part == 1 ? p0 : p0 * p1);
            }
            const int chn = jb * 168 + c0; const size_t gi = (size_t)(t0 + tt) * LW + chn;
            const uint4 gv = ggpre[it]; const unsigned gw4[4] = {gv.x, gv.y, gv.z, gv.w}; unsigned o1[4], o2[4];
#pragma unroll
            for (int i = 0; i < 4; ++i) {
                const float g0 = __uint_as_float(gw4[i] << 16), g1 = __uint_as_float(gw4[i] & 0xffff0000u);
                o1[i] = pg8::cvt_pk_bf16((hl[2 * i] + pl[2 * i] * chh[2 * i]) * g0, (hl[2 * i + 1] + pl[2 * i + 1] * chh[2 * i + 1]) * g1);
                o2[i] = pg8::cvt_pk_bf16(pl[2 * i] * cpp[2 * i] * g0, pl[2 * i + 1] * cpp[2 * i + 1] * g1);
            }
            *(uint4*)(a1 + (size_t)(t0 + tt) * LWP + chn) = make_uint4(o1[0], o1[1], o1[2], o1[3]);
            *(uint4*)(gg + gi) = make_uint4(o2[0], o2[1], o2[2], o2[3]);
        }
        if (tid < 168) {
            const float p0 = PE[tid], h0 = HE[tid], p1 = PE[168 + tid], h1v = HE[168 + tid], p2 = PE[336 + tid], h2 = HE[336 + tid];
            const int chn = jb * 168 + tid;
            sums[((size_t)chn * 256 + tile) * 2] = p0 * p1 * p2; sums[((size_t)chn * 256 + tile) * 2 + 1] = (h0 * p1 + h1v) * p2 + h2;
        }
        __syncthreads();
    }
}
__device__ void lru_pass2(const Params& P) {
    const int lane = threadIdx.x & 63, w = threadIdx.x >> 6;
    const float* sums = (const float*)((unsigned char*)P.out + OUT_SUMS); float* carry = (float*)((unsigned char*)P.out + OUT_CARRY);
    for (int chn = blockIdx.x * 8 + w; chn < LW; chn += gridDim.x * 8) {
        const f32x4 s0 = *(const f32x4*)(sums + ((size_t)chn * 256 + 4 * lane) * 2), s1 = *(const f32x4*)(sums + ((size_t)chn * 256 + 4 * lane) * 2 + 4);
        const float p[4] = {s0[0], s0[2], s1[0], s1[2]}, hh[4] = {s0[1], s0[3], s1[1], s1[3]};
        float Pa = 1.f, Ha = 0.f;
#pragma unroll
        for (int i = 0; i < 4; ++i) { Ha = p[i] * Ha + hh[i]; Pa *= p[i]; }
#pragma unroll
        for (int d = 1; d < 64; d <<= 1) { const float Pp = __shfl_up(Pa, d), Hp = __shfl_up(Ha, d); if (lane >= d) { Ha = Pa * Hp + Ha; Pa = Pa * Pp; } }
        float c = __shfl_up(Ha, 1); if (lane == 0) c = 0.f;
#pragma unroll
        for (int i = 0; i < 4; ++i) { carry[(size_t)(4 * lane + i) * LW + chn] = c; c = p[i] * c + hh[i]; }
    }
}
__device__ void lru_pass3(const Params& P) {
    bf16_t* a1 = (bf16_t*)(P.ws + WS_HB); const bf16_t* a2 = (const bf16_t*)(P.ws + WS_GG); const float* carry = (const float*)((unsigned char*)P.out + OUT_CARRY);
    const int nthr = gridDim.x * blockDim.x;
    for (int idx = blockIdx.x * blockDim.x + threadIdx.x; idx < SEQ * 176; idx += nthr) {
        const int t = idx / 176, g8 = idx % 176, c0 = g8 * 8; bf16_t* dst = a1 + (size_t)t * LWP + c0;
        if (g8 >= 168) { *(uint4*)dst = make_uint4(0u, 0u, 0u, 0u); continue; }
        const uint4 x1 = *(const uint4*)dst, x2 = *(const uint4*)(a2 + (size_t)t * LW + c0);
        const f32x4 ca = *(const f32x4*)(carry + (size_t)(t >> 6) * LW + c0), cbv = *(const f32x4*)(carry + (size_t)(t >> 6) * LW + c0 + 4);
        const unsigned w1[4] = {x1.x, x1.y, x1.z, x1.w}, w2[4] = {x2.x, x2.y, x2.z, x2.w}; const float cc[8] = {ca[0], ca[1], ca[2], ca[3], cbv[0], cbv[1], cbv[2], cbv[3]};
        unsigned o[4];
#pragma unroll
        for (int i = 0; i < 4; ++i) {
            const float lo = __uint_as_float(w1[i] << 16) + __uint_as_float(w2[i] << 16) * cc[2 * i], hi = __uint_as_float(w1[i] & 0xffff0000u) + __uint_as_float(w2[i] & 0xffff0000u) * cc[2 * i + 1];
            o[i] = pg8::cvt_pk_bf16(lo, hi);
        }
        *(uint4*)dst = make_uint4(o[0], o[1], o[2], o[3]);
    }
}

#define XB_XCNT(j)  (256  + 64 * (j))
#define XB_XSUB(j)  (1280 + 64 * (j))
#define XB_XGEN(j)  (2304 + 64 * (j))
#define XB_TOP      3328
#define XB_TOPGEN   3392
#define XCD_BAR_WORDS 3456
constexpr size_t WS_BAR = 255 * MiB + 512 * 1024;
constexpr int LDS_BARST = LDS_BYTES - 64;
__device__ __forceinline__ unsigned xb_ld(unsigned* p)              { return __hip_atomic_load(p, __ATOMIC_RELAXED, __HIP_MEMORY_SCOPE_AGENT); }
__device__ __forceinline__ unsigned xb_add(unsigned* p, unsigned v) { return __hip_atomic_fetch_add(p, v, __ATOMIC_RELAXED, __HIP_MEMORY_SCOPE_AGENT); }
__device__ __forceinline__ unsigned xb_xcc_id() { return (unsigned)__builtin_amdgcn_s_getreg((3 << 11) | 20) & 0xFu; }
__device__ __forceinline__ void gbar(unsigned* bar, volatile PG8_LAS unsigned* st, unsigned k) {
    asm volatile("s_waitcnt vmcnt(0)" ::: "memory");
    __syncthreads();
    if (threadIdx.x == 0) {
        const unsigned x = xb_xcc_id(), nloc = st[0], nx = st[1];
        const unsigned old = xb_add(&bar[XB_XSUB(x)], 1u);
        if (old + 1u == (k + 1u) * nloc) {
            __builtin_amdgcn_fence(__ATOMIC_RELEASE, "agent");
            asm volatile("s_waitcnt vmcnt(0)" ::: "memory");
            const unsigned og = xb_add(&bar[XB_TOP], 1u);
            if (og + 1u == (k + 1u) * nx) xb_add(&bar[XB_TOPGEN], 1u);
            else while (xb_ld(&bar[XB_TOPGEN]) == k) __builtin_amdgcn_s_sleep(1);
            xb_add(&bar[XB_XGEN(x)], 1u);
            __builtin_amdgcn_fence(__ATOMIC_ACQUIRE, "agent");
            asm volatile("s_waitcnt vmcnt(0)" ::: "memory");
        } else {
            while (xb_ld(&bar[XB_XGEN(x)]) == k) __builtin_amdgcn_s_sleep(1);
            __builtin_amdgcn_fence(__ATOMIC_ACQUIRE, "agent");
            asm volatile("s_waitcnt vmcnt(0)" ::: "memory");
        }
    }
    __syncthreads();
}
template <class Epi> __device__ __forceinline__ void run_gemm(PG8_LAS unsigned char* lds, const bf16_t* A, const bf16_t* Bt, int M, int N, int K, const Epi& E, int a_tile_rows = 256, int stagger = 0) {
    if (stagger) { const unsigned long long t0 = wall_clock64(), d = (unsigned long long)(((blockIdx.x >> 3) & 3) * stagger); while (wall_clock64() - t0 < d) __builtin_amdgcn_s_sleep(4); }
    pg8::Gemm g{A, Bt, M, N, K, a_tile_rows}; pg8::StaticOrder S; S.init(M, N, (int)gridDim.x, (int)blockIdx.x);
    pg8::gemm_phase<Epi, pg8::StaticOrder, false>(lds, g, S, E, nullptr);
}

__global__ void __launch_bounds__(512, 2) fwd_megakernel(Params P) {
    extern __shared__ __attribute__((aligned(16))) unsigned char smem[];
    cg::grid_group grid = cg::this_grid();
    PG8_LAS unsigned char* lds = (PG8_LAS unsigned char*)smem;
    if (threadIdx.x == 0) (void)xb_add((unsigned*)(P.ws + WS_BAR) + XB_XCNT(xb_xcc_id()), 1u);
    if (P.out == nullptr) grid.sync();
    unsigned char* ws = P.ws; unsigned char* ob = (unsigned char*)P.out;
    bf16_t* h1 = (bf16_t*)(ob + OUT_H1); bf16_t* sB = (bf16_t*)(ob + OUT_SB); bf16_t* yas = (bf16_t*)(ob + OUT_YAS);
    bf16_t* Wup = (bf16_t*)(ws + WS_WUP); bf16_t* Wdown = (bf16_t*)(ws + WS_WDOWN); bf16_t* Wout = (bf16_t*)(ws + WS_WOUT); bf16_t* Wglao = (bf16_t*)(ws + WS_GLAWO); bf16_t* Wlruo = (bf16_t*)(ws + WS_LRUWO); bf16_t* Win = (bf16_t*)(ws + WS_WIN);
    float* rowsq = (float*)(ws + WS_ROWSQ);

#ifndef PROBE_A
#define PROBE_A -1
#define PROBE_B -1
#endif
    unsigned long long tA = 0, tB = 0; unsigned bar_k = 0;
#define STAMP(k) do { if ((k) == PROBE_A) tA = wall_clock64(); if ((k) == PROBE_B) tB = wall_clock64(); } while (0)
    STAMP(0);
    rmsnorm_rows_bf16(P.in[0], P.in[1], h1);
    transpose_range<0, 1984>(P, (float*)smem, (int)blockIdx.x, (int)gridDim.x);
    transpose_range<5152, NTILES_ALL>(P, (float*)smem, (int)blockIdx.x, (int)gridDim.x);
    for (int i = blockIdx.x * blockDim.x + threadIdx.x; i < SEQ; i += gridDim.x * blockDim.x) rowsq[i] = 0.f;
    for (int i = blockIdx.x * blockDim.x + threadIdx.x; i < LW; i += gridDim.x * blockDim.x) { const float av = P.in[13][i]; ((float*)(ws + WS_SP))[i] = fmaxf(av, 0.f) + log1pf(__expf(-fabsf(av))); }
    if (threadIdx.x == 0) {
        unsigned mine, cnt; const unsigned x = xb_xcc_id();
        for (;;) { unsigned sum = 0u; mine = 0u; cnt = 0u;
            for (unsigned j = 0; j < 16; ++j) { const unsigned c = xb_ld((unsigned*)(P.ws + WS_BAR) + XB_XCNT(j)); sum += c; cnt += c > 0u ? 1u : 0u; mine = j == x ? c : mine; }
            if (sum == gridDim.x) break;
            __builtin_amdgcn_s_sleep(2); }
        ((volatile PG8_LAS unsigned*)(lds + LDS_BARST))[0] = mine; ((volatile PG8_LAS unsigned*)(lds + LDS_BARST))[1] = cnt;
    }
    __syncthreads();
    gbar((unsigned*)(P.ws + WS_BAR), (volatile PG8_LAS unsigned*)(lds + LDS_BARST), bar_k++);
    STAMP(1);
    { EpiGen<F1> E{F1{(bf16_t*)(ws + WS_Q), (bf16_t*)(ws + WS_K), (bf16_t*)(ws + WS_V), (bf16_t*)(ws + WS_G), (bf16_t*)(ws + WS_SA), sB, (bf16_t*)(ws + WS_XL), (bf16_t*)(ws + WS_GG), (float*)(ws + WS_FLOW)}};
      run_gemm(lds, h1, Win, SEQ, NP, DM, E, 256, STAG); }
    gbar((unsigned*)(P.ws + WS_BAR), (volatile PG8_LAS unsigned*)(lds + LDS_BARST), bar_k++);
    STAMP(2);
#ifdef NAIVE_GLA
    gla_naive(P, (float*)smem);
    gbar((unsigned*)(P.ws + WS_BAR), (volatile PG8_LAS unsigned*)(lds + LDS_BARST), bar_k++);
#else
    gla_pass<false>(P, lds);
    gbar((unsigned*)(P.ws + WS_BAR), (volatile PG8_LAS unsigned*)(lds + LDS_BARST), bar_k++);
    STAMP(3);
    gla_scan(P);
    transpose_range<4288, 5152>(P, (float*)smem, (int)blockIdx.x, (int)gridDim.x);
    gbar((unsigned*)(P.ws + WS_BAR), (volatile PG8_LAS unsigned*)(lds + LDS_BARST), bar_k++);
    STAMP(4);
    gla_pass<true>(P, lds);
    gbar((unsigned*)(P.ws + WS_BAR), (volatile PG8_LAS unsigned*)(lds + LDS_BARST), bar_k++);
    STAMP(5);
#endif
#ifdef NAIVE_LRU
    lru_naive(P, (float*)smem);
    gbar((unsigned*)(P.ws + WS_BAR), (volatile PG8_LAS unsigned*)(lds + LDS_BARST), bar_k++);
#else
    lru_pass1(P, lds);
    gbar((unsigned*)(P.ws + WS_BAR), (volatile PG8_LAS unsigned*)(lds + LDS_BARST), bar_k++);
    STAMP(6);
    lru_pass2(P);
    transpose_range<1984, 3520>(P, (float*)smem, (int)blockIdx.x, (int)gridDim.x);
    gbar((unsigned*)(P.ws + WS_BAR), (volatile PG8_LAS unsigned*)(lds + LDS_BARST), bar_k++);
    STAMP(7);
    lru_pass3(P);
    gbar((unsigned*)(P.ws + WS_BAR), (volatile PG8_LAS unsigned*)(lds + LDS_BARST), bar_k++);
    STAMP(8);
#endif
    { EpiGen<F2> E{F2{(const bf16_t*)(ws + WS_SA), yas}}; run_gemm(lds, (const bf16_t*)(ws + WS_G), Wglao, SEQ, DM, DM, E); }
    { EpiGen<F3> E{F3{sB, yas, (bf16_t*)(ws + WS_MERGED)}}; run_gemm(lds, (const bf16_t*)(ws + WS_HB), Wlruo, SEQ, DM, LWP, E); }
    gbar((unsigned*)(P.ws + WS_BAR), (volatile PG8_LAS unsigned*)(lds + LDS_BARST), bar_k++);
    STAMP(9);
    if (blockIdx.x == 0) for (int i = threadIdx.x; i < 2 * DM / 2; i += 512) ((unsigned*)(ws + WS_X1B))[i] = 0u;
    { E4 E{P.in[0], P.out, (bf16_t*)(ws + WS_X1B), rowsq}; run_gemm(lds, (const bf16_t*)(ws + WS_MERGED), Wout, SEQ, DM, DM, E); }
    gbar((unsigned*)(P.ws + WS_BAR), (volatile PG8_LAS unsigned*)(lds + LDS_BARST), bar_k++);
    STAMP(10);
    { E5f E{rowsq, P.in[18], P.in[19], (bf16_t*)(ws + WS_ACT), (PG8_LAS float*)(lds + XCH_OFF)}; run_gemm(lds, (const bf16_t*)(ws + WS_X1B), Wup, 65 * 256, 2 * DFF, DM, E, 254, STAG);
      transpose_in_idle_slot<3520, 4288>(P, (float*)smem, 65 * 24); }
    gbar((unsigned*)(P.ws + WS_BAR), (volatile PG8_LAS unsigned*)(lds + LDS_BARST), bar_k++);
    STAMP(14);
    { E6 E{P.out, (const bf16_t*)(ws + WS_X1B)}; run_gemm(lds, (const bf16_t*)(ws + WS_ACT), Wdown, SEQ, DM, DFF, E); }
    gbar((unsigned*)(P.ws + WS_BAR), (volatile PG8_LAS unsigned*)(lds + LDS_BARST), bar_k++);
    STAMP(15);
    rmsnorm_rows_inplace(P.out, P.in[21]);
    if (PROBE_A >= 0) { gbar((unsigned*)(P.ws + WS_BAR), (volatile PG8_LAS unsigned*)(lds + LDS_BARST), bar_k++); STAMP(16); if (blockIdx.x == 0 && threadIdx.x == 0) { const unsigned long long t0 = wall_clock64(); while (wall_clock64() - t0 < tB - tA) __builtin_amdgcn_s_sleep(8); } }
}

extern "C" void kernel_launch(void* const* d_in, const int* in_sizes, int n_in, void* d_out, int out_size, void* d_ws, size_t ws_size, hipStream_t stream) {
    static int grid_blocks = 0;
    if (grid_blocks == 0) {
        int dev = 0, cus = 0, per_cu = 0;
        hipGetDevice(&dev);
        hipDeviceGetAttribute(&cus, hipDeviceAttributeMultiprocessorCount, dev);
        if (hipFuncSetAttribute((const void*)fwd_megakernel, hipFuncAttributeMaxDynamicSharedMemorySize, LDS_BYTES) != hipSuccess) { fprintf(stderr, "hipFuncSetAttribute failed\n"); grid_blocks = -1; return; }
        if (hipOccupancyMaxActiveBlocksPerMultiprocessor(&per_cu, (const void*)fwd_megakernel, 512, LDS_BYTES) != hipSuccess || per_cu < 1) { fprintf(stderr, "occupancy query: %d\n", per_cu); per_cu = 1; }
        (void)hipGetLastError();
        grid_blocks = cus * per_cu;
        if (n_in != 22 || ws_size < 256 * MiB) { fprintf(stderr, "unexpected n_in %d / ws_size %zu\n", n_in, ws_size); }
    }
    if (grid_blocks < 0) return;
    Params p{};
    for (int i = 0; i < 22; ++i) p.in[i] = (const float*)d_in[i];
    p.out = (float*)d_out; p.ws = (unsigned char*)d_ws;
    if (hipMemsetAsync((unsigned char*)d_ws + WS_BAR, 0, XCD_BAR_WORDS * sizeof(unsigned), stream) != hipSuccess) { fprintf(stderr, "memset of barrier words failed\n"); return; }
    void* args[] = {&p};
    hipError_t e = hipLaunchCooperativeKernel((const void*)fwd_megakernel, dim3(grid_blocks), dim3(512), args, LDS_BYTES, stream);
    if (e != hipSuccess) fprintf(stderr, "cooperative launch failed: %s (grid %d)\n", hipGetErrorString(e), grid_blocks);
}
```

```cpp
#include <hip/hip_runtime.h>
#include <hip/hip_cooperative_groups.h>
#include <cstdio>
namespace cg = cooperative_groups;
namespace pg8 {
#define PG8_LAS __attribute__((address_space(3)))
typedef unsigned short bf16_t;
typedef short bf16x8 __attribute__((ext_vector_type(8)));
typedef float f32x4 __attribute__((ext_vector_type(4)));
typedef unsigned u32x4 __attribute__((ext_vector_type(4)));
constexpr int BM = 256, BK = 64, HALF = 128, HTB = HALF * BK * 2  , STAGE_BYTES = 8 * HTB, NXCD = 8, WGM = 8;

__host__ __device__ __forceinline__ int lds_byte(int r, int c) { const int st = (r >> 4) * 2 + (c >> 5), rr = r & 15, cc = c & 31, ob = rr * 64 + cc * 2; return st * 1024 + (ob ^ (((ob >> 9) & 1) << 5)); }
__host__ __device__ __forceinline__ void stage_rc(int b, int& R, int& C) { const int st = b / 1024, sb = b % 1024, swz = sb ^ (((sb >> 9) & 1) << 5); R = (st >> 1) * 16 + swz / 64; C = (st & 1) * 32 + (swz % 64) / 2; }
__host__ __device__ __forceinline__ int perm32(int rho) { const int n = rho >> 4, i = rho & 15; return 8 * (i >> 2) + 4 * n + (i & 3); }

struct Unit { int pm, pn; };
struct Gemm { const bf16_t* A; const bf16_t* Bt; int M, N, K; int a_tile_rows; };

struct StaticOrder {
    int nM, nN, nwg, G, c;
    __host__ __device__ void init(int M, int N, int G_, int c_) { nM = M / BM; nN = N / BM; nwg = nM * nN; G = G_; c = c_; }
    __host__ __device__ bool next(int i, Unit& u) const {
        const long L = (long)i * G + c; if (L >= nwg) return false;
        int wgid = (int)L; { const int q = nwg / NXCD, r = nwg % NXCD, xcd = wgid % NXCD, off = wgid / NXCD; wgid = (xcd < r ? xcd * (q + 1) : r * (q + 1) + (xcd - r) * q) + off; }
        const int nig = WGM * nN, gid = wgid / nig, fm = gid * WGM, gsz = (nM - fm) < WGM ? (nM - fm) : WGM;
        u.pm = fm + ((wgid % nig) % gsz); u.pn = (wgid % nig) / gsz; return true;
    }
    __device__ __forceinline__ void a_ready(const Unit&) const {}
    __device__ __forceinline__ void done(const Unit&) const {}
};
__device__ __forceinline__ unsigned cvt_pk_bf16(float lo, float hi) { unsigned r; asm volatile("v_cvt_pk_bf16_f32 %0, %1, %2" : "=v"(r) : "v"(lo), "v"(hi)); return r; }
typedef float f32x2 __attribute__((ext_vector_type(2)));
template <class Epi, class Sched, bool STAMP = false>
__device__ __forceinline__ void gemm_phase(PG8_LAS unsigned char* lds, const Gemm g, const Sched& S, const Epi& E, unsigned long long* stamps) {
    const int tid = threadIdx.x, wid = __builtin_amdgcn_readfirstlane(tid >> 6), lane = tid & 63, wr = wid >> 2, wc = wid & 3, fr = lane & 15, fq = lane >> 4;
    const int K = g.K, nt = K / BK;
    int ts_lo = 0, ts_hi = 0, nts = 0; const unsigned long long rt_entry = STAMP ? (unsigned long long)wall_clock64() : 0ull;
#define PG8_STAMP() do { if (STAMP && wid == 0 && nts < 64) { const unsigned long long _c = (unsigned long long)clock64(); \
        ts_lo = (lane == nts) ? (int)(unsigned)_c : ts_lo; ts_hi = (lane == nts) ? (int)(unsigned)(_c >> 32) : ts_hi; ++nts; } } while (0)
    PG8_STAMP();
    unsigned voffA[2], voffB[2];
#pragma unroll
    for (int i = 0; i < 2; ++i) { int R, C; stage_rc(tid * 16 + i * 8192, R, C); const int Rb = Epi::PERM ? ((R & ~31) + perm32(R & 31)) : R;
        const int Ra = Epi::APERM ? ((R & 64) + 4 * (R & 15) + ((R >> 4) & 3)) : R;
        voffA[i] = (unsigned)(Ra * K + C) * 2u; voffB[i] = (unsigned)(Rb * K + C) * 2u; }
    const size_t kstep = (size_t)(BK * 2);
    const size_t hstep = (size_t)HALF * K * 2;
    const size_t tstep = 2 * hstep; const size_t tstepA = (size_t)g.a_tile_rows * K * 2;
    const unsigned ldsw = (unsigned)wid * 1024u;
    const int aoff = lds_byte(wr * 64 + fr, fq * 8), boff = lds_byte(wc * 32 + fr, fq * 8);
#define PG8_SA(b, h) (((b) * 2 + (h)) * HTB)
#define PG8_SB(b, h) ((4 + (b) * 2 + (h)) * HTB)
#define PG8_STAGE(bufoff, gbase, voff) do { _Pragma("unroll") for (int _i = 0; _i < 2; ++_i) \
        __builtin_amdgcn_global_load_lds((const unsigned*)((const char*)(gbase) + (voff)[_i]), (PG8_LAS unsigned*)(lds + (bufoff) + ldsw + _i * 8192), 16, 0, 0); } while (0)
#define PG8_LDA(dst, b, h) do { _Pragma("unroll") for (int m = 0; m < 4; ++m) _Pragma("unroll") for (int k = 0; k < 2; ++k) dst[m][k] = *(const PG8_LAS bf16x8*)(lds + PG8_SA(b, h) + aoff + m * 2048 + k * 1024); } while (0)
#define PG8_LDB(dst, b, h) do { _Pragma("unroll") for (int n = 0; n < 2; ++n) _Pragma("unroll") for (int k = 0; k < 2; ++k) dst[n][k] = *(const PG8_LAS bf16x8*)(lds + PG8_SB(b, h) + boff + n * 2048 + k * 1024); } while (0)
#define PG8_MMA(ai, bj, At, Bt) do { __builtin_amdgcn_s_setprio(1); _Pragma("unroll") for (int m = 0; m < 4; ++m) _Pragma("unroll") for (int n = 0; n < 2; ++n) _Pragma("unroll") for (int k = 0; k < 2; ++k) \
        acc[ai][bj][m][n] = __builtin_amdgcn_mfma_f32_16x16x32_bf16(Bt[n][k], At[m][k], acc[ai][bj][m][n], 0, 0, 0); __builtin_amdgcn_s_setprio(0); } while (0)
#define PG8_WAIT_V(n) asm volatile("s_waitcnt vmcnt(" #n ")" ::: "memory")
#define PG8_WAIT_L(n) asm volatile("s_waitcnt lgkmcnt(" #n ")" ::: "memory")
#define PG8_BAR __builtin_amdgcn_s_barrier()
#define PG8_SCHED __builtin_amdgcn_sched_barrier(0)
    Unit cur, nxt; int ui = 0;
    if (!S.next(0, cur)) return;
    f32x4 acc[2][2][4][2];
#pragma unroll
    for (int a = 0; a < 2; ++a)
#pragma unroll
        for (int b = 0; b < 2; ++b)
#pragma unroll
            for (int m = 0; m < 4; ++m)
#pragma unroll
                for (int n = 0; n < 2; ++n) acc[a][b][m][n] = (f32x4){0.f, 0.f, 0.f, 0.f};
    if constexpr (Epi::HAS_INIT) E.init(acc, cur, wr, wc, fr, fq);
    bf16x8 At[4][2], B0[2][2], B1[2][2];
    const char* cA = (const char*)g.A + (size_t)cur.pm * tstepA; const char* cB = (const char*)g.Bt + (size_t)cur.pn * tstep;
    S.a_ready(cur);
    PG8_STAGE(PG8_SB(0, 0), cB, voffB); PG8_STAGE(PG8_SA(0, 0), cA, voffA); PG8_STAGE(PG8_SB(0, 1), cB + hstep, voffB); PG8_STAGE(PG8_SA(0, 1), cA + hstep, voffA);
    if (wr == 1) PG8_BAR;
    PG8_WAIT_V(4); PG8_BAR;
    PG8_STAGE(PG8_SB(1, 0), cB + kstep, voffB); PG8_STAGE(PG8_SA(1, 0), cA + kstep, voffA); PG8_STAGE(PG8_SB(1, 1), cB + hstep + kstep, voffB);
    PG8_WAIT_V(6); PG8_BAR;
    PG8_STAMP();
    for (;;) {
        const bool has_next = S.next(ui + 1, nxt);
        const char* nA = has_next ? (const char*)g.A + (size_t)nxt.pm * tstepA : cA; const char* nB = has_next ? (const char*)g.Bt + (size_t)nxt.pn * tstep : cB;
        for (int t = 0; t < nt; t += 2) {
            const bool last = (t == nt - 2);
            const char* a1 = cA + (size_t)(t + 1) * kstep;
            const char* a2 = last ? nA : cA + (size_t)(t + 2) * kstep; const char* b2 = last ? nB : cB + (size_t)(t + 2) * kstep;
            const char* a3 = a2 + kstep; const char* b3 = b2 + kstep;
            if (last && has_next) S.a_ready(nxt);
            PG8_LDB(B0, 0, 0); PG8_SCHED; PG8_LDA(At, 0, 0); PG8_STAGE(PG8_SA(1, 1), a1 + hstep, voffA);
            PG8_WAIT_L(8); PG8_BAR; PG8_WAIT_L(0); PG8_MMA(0, 0, At, B0); PG8_BAR; PG8_SCHED;
            PG8_LDB(B1, 0, 1); PG8_STAGE(PG8_SB(0, 0), b2, voffB);
            PG8_BAR; PG8_WAIT_L(0); PG8_MMA(0, 1, At, B1); PG8_BAR;
            PG8_LDA(At, 0, 1); PG8_STAGE(PG8_SA(0, 0), a2, voffA);
            PG8_BAR; PG8_WAIT_L(0); PG8_MMA(1, 0, At, B0); PG8_BAR; PG8_SCHED;
            PG8_STAGE(PG8_SB(0, 1), b2 + hstep, voffB);
            PG8_WAIT_V(6); PG8_BAR; PG8_MMA(1, 1, At, B1); PG8_BAR;
            PG8_LDB(B0, 1, 0); PG8_SCHED; PG8_LDA(At, 1, 0); PG8_STAGE(PG8_SA(0, 1), a2 + hstep, voffA);
            PG8_WAIT_L(8); PG8_BAR; PG8_WAIT_L(0); PG8_MMA(0, 0, At, B0); PG8_BAR; PG8_SCHED;
            PG8_LDB(B1, 1, 1); PG8_STAGE(PG8_SB(1, 0), b3, voffB);
            PG8_BAR; PG8_WAIT_L(0); PG8_MMA(0, 1, At, B1); PG8_BAR;
            PG8_LDA(At, 1, 1); PG8_STAGE(PG8_SA(1, 0), a3, voffA);
            PG8_BAR; PG8_WAIT_L(0); PG8_MMA(1, 0, At, B0); PG8_BAR; PG8_SCHED;
            PG8_STAGE(PG8_SB(1, 1), b3 + hstep, voffB);
            PG8_WAIT_V(6); PG8_BAR; PG8_MMA(1, 1, At, B1); PG8_BAR;
        }
        PG8_STAMP();
        if constexpr (!Epi::AFTER_DRAIN) { E(acc, cur, wr, wc, fr, fq); S.done(cur); }
        PG8_STAMP();
        if (!has_next) break;
#pragma unroll
        for (int a = 0; a < 2; ++a)
#pragma unroll
            for (int b = 0; b < 2; ++b)
#pragma unroll
                for (int m = 0; m < 4; ++m)
#pragma unroll
                    for (int n = 0; n < 2; ++n) acc[a][b][m][n] = (f32x4){0.f, 0.f, 0.f, 0.f};
        cur = nxt; cA = nA; cB = nB; ++ui;
    }
    PG8_WAIT_V(0);
    if (wr == 0) PG8_BAR;
    PG8_BAR;
    if constexpr (Epi::AFTER_DRAIN) { E.fused(acc, cur, wr, wc, fr, fq, lds, wid, lane); S.done(cur); }
    PG8_STAMP();
    if (STAMP && wid == 0) { stamps[lane] = lane < nts ? (((unsigned long long)(unsigned)ts_hi << 32) | (unsigned)ts_lo) : 0ull;
        if (lane == 62) stamps[62] = rt_entry; if (lane == 63) stamps[63] = (unsigned long long)wall_clock64(); }
#undef PG8_STAMP
#undef PG8_SA
#undef PG8_SB
#undef PG8_STAGE
#undef PG8_LDA
#undef PG8_LDB
#undef PG8_MMA
#undef PG8_WAIT_V
#undef PG8_WAIT_L
#undef PG8_BAR
#undef PG8_SCHED
}
}

typedef pg8::bf16_t bf16_t;
typedef pg8::f32x4 f32x4;
constexpr int SEQ = 16384, DM = 1024, NP = 7936, LW = 1344, LWP = 1408, DFF = 3072;
constexpr size_t MiB = (size_t)1 << 20;
constexpr size_t WS_WUP = 0, WS_WDOWN = 12 * MiB, WS_WOUT = 18 * MiB, WS_GLAWO = 20 * MiB, WS_LRUWO = 22 * MiB, WS_MISC = 25 * MiB, WS_WIN = 26 * MiB;
constexpr size_t WS_Q = 42 * MiB, WS_K = 58 * MiB, WS_V = 74 * MiB, WS_G = 106 * MiB, WS_XL = 138 * MiB, WS_GG = 180 * MiB, WS_SA = 222 * MiB, WS_FLOW = 254 * MiB, WS_ROWSQ = 255 * MiB;
constexpr size_t WS_HB = WS_Q;
constexpr size_t WS_MERGED = WS_XL;
constexpr size_t WS_X1B = 20 * MiB;
constexpr size_t WS_U = 52 * MiB;
constexpr size_t WS_HSAVE = 148 * MiB;
constexpr size_t WS_ACT = 56 * MiB;
constexpr size_t OUT_H1 = 0, OUT_SB = 32 * MiB, OUT_YAS = 0;
constexpr int LDS_BYTES = 160 * 1024;

#ifndef STAG
#define STAG 0
#endif
struct Params { const float* in[22]; float* out; unsigned char* ws; };

__device__ __forceinline__ float bf2f(bf16_t b) { return __uint_as_float(((unsigned)b) << 16); }
__device__ __forceinline__ void st4(bf16_t* p, f32x4 a) { uint2 w; w.x = pg8::cvt_pk_bf16(a[0], a[1]); w.y = pg8::cvt_pk_bf16(a[2], a[3]); *(uint2*)p = w; }
__device__ __forceinline__ f32x4 ld4(const bf16_t* p) { const uint2 w = *(const uint2*)p; f32x4 r; r[0] = __uint_as_float(w.x << 16); r[1] = __uint_as_float(w.x & 0xffff0000u); r[2] = __uint_as_float(w.y << 16); r[3] = __uint_as_float(w.y & 0xffff0000u); return r; }
__device__ __forceinline__ float sigm(float x) { return __builtin_amdgcn_rcpf(1.f + __builtin_amdgcn_exp2f(-1.4426950408889634f * x)); }
__device__ __forceinline__ float gelu_t(float x) { const float y = x * (-2.302208198f + -0.10294324f * x * x); return x * __builtin_amdgcn_rcpf(1.f + __builtin_amdgcn_exp2f(y)); }
__device__ __forceinline__ float wave_sum(float s) {
#pragma unroll
    for (int o = 32; o >= 1; o >>= 1) s += __shfl_xor(s, o);
    return s;
}

__device__ void rmsnorm_rows_bf16(const float* x, const float* g, bf16_t* out) {
    const int wave = threadIdx.x >> 6, lane = threadIdx.x & 63;
    for (int row = blockIdx.x * 8 + wave; row < SEQ; row += gridDim.x * 8) {
        const float* xr = x + (size_t)row * DM; f32x4 v[4]; float ss = 0.f;
#pragma unroll
        for (int i = 0; i < 4; ++i) { v[i] = __builtin_nontemporal_load((const f32x4*)(xr + i * 256 + lane * 4));     ss += v[i][0] * v[i][0] + v[i][1] * v[i][1] + v[i][2] * v[i][2] + v[i][3] * v[i][3]; }
        ss = wave_sum(ss);
        const float r = rsqrtf(ss * (1.0f / DM) + 1e-6f);
#pragma unroll
        for (int i = 0; i < 4; ++i) { const f32x4 gv = *(const f32x4*)(g + i * 256 + lane * 4); st4(out + (size_t)row * DM + i * 256 + lane * 4, v[i] * r * gv); }
    }
}
__device__ void rmsnorm_rows_inplace(float* x, const float* g) {
    const int wave = threadIdx.x >> 6, lane = threadIdx.x & 63;
    for (int row = blockIdx.x * 8 + wave; row < SEQ; row += gridDim.x * 8) {
        float* xr = x + (size_t)row * DM; f32x4 v[4]; float ss = 0.f;
#pragma unroll
        for (int i = 0; i < 4; ++i) { v[i] = *(const f32x4*)(xr + i * 256 + lane * 4); ss += v[i][0] * v[i][0] + v[i][1] * v[i][1] + v[i][2] * v[i][2] + v[i][3] * v[i][3]; }
        ss = wave_sum(ss);
        const float r = rsqrtf(ss * (1.0f / DM) + 1e-6f);
#pragma unroll
        for (int i = 0; i < 4; ++i) { const f32x4 gv = *(const f32x4*)(g + i * 256 + lane * 4); *(f32x4*)(xr + i * 256 + lane * 4) = v[i] * r * gv; }
    }
}
__device__ __forceinline__ int colmap_win(int n) {
    if (n < 3072) return n;
    if (n < 4096) return 5776 + (n - 3072);
    if (n < 5120) return 6800 + (n - 4096);
    if (n < 6464) return 3088 + (n - 5120);
    if (n < 7808) return 4432 + (n - 6464);
    if (n < 7824) return 3072 + (n - 7808);
    return -1;
}
__device__ __forceinline__ int colmap_wup(int n) { return ((n >> 7) & 1 ? DFF : 0) + 128 * (n >> 8) + (n & 127); }
constexpr size_t WS_GATEW0 = 24 * MiB + 768 * 1024;
constexpr int NTILES_ALL = 1984 + 1536 + 768 + 352 + 256 + 256 + 144;
struct TDesc { const float* src; const float* rs; bf16_t* dst; int srcK, srcLd, srcNv, dstK, tk, mode, lt; };
__device__ __forceinline__ TDesc get_desc(const Params& P, int t) {
    unsigned char* ws = P.ws; TDesc d;
    if (t < 1984) { d = TDesc{P.in[2], nullptr, (bf16_t*)(ws + WS_WIN), 1024, 7824, 7824, 1024, 16, 1, t}; }
    else if (t < 3520) { d = TDesc{P.in[17], P.in[16], (bf16_t*)(ws + WS_WUP), 1024, 6144, 6144, 1024, 16, 2, t - 1984}; }
    else if (t < 4288) { d = TDesc{P.in[20], nullptr, (bf16_t*)(ws + WS_WDOWN), 3072, 1024, 1024, 3072, 48, 0, t - 3520}; }
    else if (t < 4640) { d = TDesc{P.in[14], nullptr, (bf16_t*)(ws + WS_LRUWO), 1344, 1024, 1024, 1408, 22, 0, t - 4288}; }
    else if (t < 4896) { d = TDesc{P.in[6], nullptr, (bf16_t*)(ws + WS_GLAWO), 1024, 1024, 1024, 1024, 16, 0, t - 4640}; }
    else if (t < 5152) { d = TDesc{P.in[15], nullptr, (bf16_t*)(ws + WS_WOUT), 1024, 1024, 1024, 1024, 16, 0, t - 4896}; }
    else { const int u = t - 5152, gsel = u / 9; d = TDesc{(gsel & 1 ? P.in[11] : P.in[9]) + (size_t)(gsel >> 1) * 168 * 168, nullptr, (bf16_t*)(ws + WS_GATEW0) + (size_t)gsel * 192 * 192, 168, 168, 168, 192, 3, 0, u - gsel * 9}; }
    return d;
}
template <int lo, int hi> __device__ void transpose_range(const Params& P, float* tile, int rank, int nranks) {
    const int lane = threadIdx.x & 63, i8 = threadIdx.x >> 6, nl = threadIdx.x >> 3, kg = threadIdx.x & 7;
    for (int base = lo + rank * 2; base < hi; base += nranks * 2) {
        float val[2][8];
#pragma unroll
        for (int u = 0; u < 2; ++u) {
            const int t = base + u;
            if (t < hi) {
                __builtin_assume(t >= lo && t < hi);
                const TDesc d = get_desc(P, t); const int k0 = (d.lt % d.tk) * 64, n0 = (d.lt / d.tk) * 64, n = n0 + (lane & 15) * 4;
                const int sc = d.mode == 1 ? colmap_win(n) : (d.mode == 2 ? colmap_wup(n) : (n < d.srcNv ? n : -1));
#pragma unroll
                for (int j = 0; j < 2; ++j) { const int k = k0 + i8 * 8 + j * 4 + (lane >> 4); f32x4 x = {0.f, 0.f, 0.f, 0.f};
                    if (sc >= 0 && k < d.srcK) { x = __builtin_nontemporal_load((const f32x4*)(d.src + (size_t)k * d.srcLd + sc)); if (d.rs) x = x * d.rs[k]; }
                    val[u][4 * j] = x[0]; val[u][4 * j + 1] = x[1]; val[u][4 * j + 2] = x[2]; val[u][4 * j + 3] = x[3]; }
            }
        }
#pragma unroll
        for (int u = 0; u < 2; ++u)
#pragma unroll
            for (int j = 0; j < 8; ++j) tile[u * 4160 + (i8 * 8 + (j >> 2) * 4 + (lane >> 4)) * 65 + (lane & 15) * 4 + (j & 3)] = val[u][j];
        __syncthreads();
#pragma unroll
        for (int u = 0; u < 2; ++u) {
            const int t = base + u;
            if (t < hi) {
                __builtin_assume(t >= lo && t < hi);
                const TDesc d = get_desc(P, t); const int k0 = (d.lt % d.tk) * 64, n0 = (d.lt / d.tk) * 64;
                float f[8];
#pragma unroll
                for (int j = 0; j < 8; ++j) f[j] = tile[u * 4160 + (kg * 8 + j) * 65 + nl];
                uint4 w; w.x = pg8::cvt_pk_bf16(f[0], f[1]); w.y = pg8::cvt_pk_bf16(f[2], f[3]); w.z = pg8::cvt_pk_bf16(f[4], f[5]); w.w = pg8::cvt_pk_bf16(f[6], f[7]);
                *(uint4*)(d.dst + (size_t)(n0 + nl) * d.dstK + k0 + kg * 8) = w;
            }
        }
        __syncthreads();
    }
}
template <int lo, int hi> __device__ __forceinline__ void transpose_in_idle_slot(const Params& P, float* tile, int n_units) {
    const int G = (int)gridDim.x, r = n_units % G;
    const int rank = r == 0 ? (int)blockIdx.x : (int)blockIdx.x - r, nranks = r == 0 ? G : G - r;
    if (rank >= 0) transpose_range<lo, hi>(P, tile, rank, nranks);
}

typedef unsigned u32x4n __attribute__((ext_vector_type(4)));
#ifndef NT_STORE
#define NT_STORE 0
#endif
__device__ __forceinline__ void st8(bf16_t* p, f32x4 a, f32x4 b) { u32x4n w; w[0] = pg8::cvt_pk_bf16(a[0], a[1]); w[1] = pg8::cvt_pk_bf16(a[2], a[3]); w[2] = pg8::cvt_pk_bf16(b[0], b[1]); w[3] = pg8::cvt_pk_bf16(b[2], b[3]);
    if (NT_STORE) __builtin_nontemporal_store(w, (u32x4n*)p); else *(u32x4n*)p = w; }
__device__ __forceinline__ void ld8(const bf16_t* p, f32x4& a, f32x4& b) { const uint4 w = *(const uint4*)p; a[0] = __uint_as_float(w.x << 16); a[1] = __uint_as_float(w.x & 0xffff0000u); a[2] = __uint_as_float(w.y << 16); a[3] = __uint_as_float(w.y & 0xffff0000u);
    b[0] = __uint_as_float(w.z << 16); b[1] = __uint_as_float(w.z & 0xffff0000u); b[2] = __uint_as_float(w.w << 16); b[3] = __uint_as_float(w.w & 0xffff0000u); }
template <class F> struct EpiGen {
    static constexpr bool PERM = true, AFTER_DRAIN = false, APERM = false, HAS_INIT = false; F f;
    __device__ __forceinline__ void operator()(f32x4 (&acc)[2][2][4][2], const pg8::Unit& u, int wr, int wc, int fr, int fq) const {
#pragma unroll
        for (int ai = 0; ai < 2; ++ai)
#pragma unroll
            for (int m = 0; m < 4; ++m) { const int row = u.pm * 256 + ai * 128 + wr * 64 + m * 16 + fr;
#pragma unroll
                for (int bj = 0; bj < 2; ++bj) f(row, u.pn * 256 + bj * 128 + wc * 32 + 8 * fq, acc[ai][bj][m][0], acc[ai][bj][m][1], u.pn * 256 + bj * 128 + wc * 32); }
    }
};
__device__ __forceinline__ f32x4 sigm4(f32x4 a) { f32x4 s; s[0] = sigm(a[0]); s[1] = sigm(a[1]); s[2] = sigm(a[2]); s[3] = sigm(a[3]); return s; }
__device__ __forceinline__ f32x4 gelu4(f32x4 a) { f32x4 s; s[0] = gelu_t(a[0]); s[1] = gelu_t(a[1]); s[2] = gelu_t(a[2]); s[3] = gelu_t(a[3]); return s; }
struct F1 {
    bf16_t *q, *k, *v, *g, *sA, *sB, *xl, *gg; float* flow;
    __device__ __forceinline__ void operator()(int row, int col, f32x4 a, f32x4 b, int cu) const {
        if (cu < 3072) {
            bf16_t* base; int ld, c;
            if (cu < 512) { base = q; ld = 512; c = col; } else if (cu < 1024) { base = k; ld = 512; c = col - 512; } else if (cu < 2048) { base = v; ld = 1024; c = col - 1024; } else { base = g; ld = 1024; c = col - 2048; }
            st8(base + (size_t)row * ld + c, a, b);
        } else if (cu < 5120) {
            if (cu < 4096) st8(sA + (size_t)row * DM + (col - 3072), sigm4(a), sigm4(b)); else st8(sB + (size_t)row * DM + (col - 4096), sigm4(a), sigm4(b));
        } else if (cu < 6464) { st8(xl + (size_t)row * LW + (col - 5120), a, b);
        } else if (cu < 7808) { st8(gg + (size_t)row * LW + (col - 6464), gelu4(a), gelu4(b));
        } else if (col < 7824) { float* p = flow + (size_t)row * 16 + (col - 7808); *(f32x4*)p = a; *(f32x4*)(p + 4) = b; }
    }
};
struct F2 {
    const bf16_t* sA; bf16_t* yas;
    __device__ __forceinline__ void operator()(int row, int col, f32x4 a, f32x4 b, int) const { const size_t o = (size_t)row * DM + col; f32x4 s0, s1; ld8(sA + o, s0, s1); st8(yas + o, s0 * a, s1 * b); }
};
struct F3 {
    const bf16_t *sB, *yas; bf16_t* merged;
    __device__ __forceinline__ void operator()(int row, int col, f32x4 a, f32x4 b, int) const { const size_t o = (size_t)row * DM + col; f32x4 s0, s1, y0, y1; ld8(sB + o, s0, s1); ld8(yas + o, y0, y1); st8(merged + o, y0 + s0 * a, y1 + s1 * b); }
};
constexpr int X1B_ROWS = 65 * 254 + 2;
struct E4 {
    static constexpr bool PERM = true, AFTER_DRAIN = false, APERM = false, HAS_INIT = true;
    const float* x; float* x1; bf16_t* x1b; float* rowsq;
    __device__ __forceinline__ void init(f32x4 (&acc)[2][2][4][2], const pg8::Unit& u, int wr, int wc, int fr, int fq) const {
#pragma unroll
        for (int ai = 0; ai < 2; ++ai)
#pragma unroll
            for (int m = 0; m < 4; ++m)
#pragma unroll
                for (int bj = 0; bj < 2; ++bj) { const float* p = x + (size_t)(u.pm * 256 + ai * 128 + wr * 64 + m * 16 + fr) * DM + u.pn * 256 + bj * 128 + wc * 32 + 8 * fq; acc[ai][bj][m][0] = *(const f32x4*)p; acc[ai][bj][m][1] = *(const f32x4*)(p + 4); }
    }
    __device__ __forceinline__ void operator()(f32x4 (&acc)[2][2][4][2], const pg8::Unit& u, int wr, int wc, int fr, int fq) const {
#pragma unroll
        for (int ai = 0; ai < 2; ++ai)
#pragma unroll
            for (int m = 0; m < 4; ++m) { const int row = u.pm * 256 + ai * 128 + wr * 64 + m * 16 + fr; float ss = 0.f;
#pragma unroll
                for (int bj = 0; bj < 2; ++bj) { const size_t o = (size_t)row * DM + u.pn * 256 + bj * 128 + wc * 32 + 8 * fq;
                    const f32x4 r0 = acc[ai][bj][m][0], r1 = acc[ai][bj][m][1];
                    st8(x1b + o + 2 * DM, r0, r1);
                    ss += r0[0] * r0[0] + r0[1] * r0[1] + r0[2] * r0[2] + r0[3] * r0[3] + r1[0] * r1[0] + r1[1] * r1[1] + r1[2] * r1[2] + r1[3] * r1[3]; }
                ss += __shfl_xor(ss, 16); ss += __shfl_xor(ss, 32);
                if (fq == 0) atomicAdd(rowsq + row, ss); }
    }
};
struct E6 {
    static constexpr bool PERM = true, AFTER_DRAIN = false, APERM = false, HAS_INIT = true;
    float* xo; const bf16_t* x1b;
    __device__ __forceinline__ void init(f32x4 (&acc)[2][2][4][2], const pg8::Unit& u, int wr, int wc, int fr, int fq) const {
#pragma unroll
        for (int ai = 0; ai < 2; ++ai)
#pragma unroll
            for (int m = 0; m < 4; ++m)
#pragma unroll
                for (int bj = 0; bj < 2; ++bj) { const bf16_t* p = x1b + (size_t)(2 + u.pm * 256 + ai * 128 + wr * 64 + m * 16 + fr) * DM + u.pn * 256 + bj * 128 + wc * 32 + 8 * fq; ld8(p, acc[ai][bj][m][0], acc[ai][bj][m][1]); }
    }
    __device__ __forceinline__ void operator()(f32x4 (&acc)[2][2][4][2], const pg8::Unit& u, int wr, int wc, int fr, int fq) const {
#pragma unroll
        for (int ai = 0; ai < 2; ++ai)
#pragma unroll
            for (int m = 0; m < 4; ++m)
#pragma unroll
                for (int bj = 0; bj < 2; ++bj) { float* p = xo + (size_t)(u.pm * 256 + ai * 128 + wr * 64 + m * 16 + fr) * DM + u.pn * 256 + bj * 128 + wc * 32 + 8 * fq; *(f32x4*)p = acc[ai][bj][m][0]; *(f32x4*)(p + 4) = acc[ai][bj][m][1]; }
    }
};
constexpr int XCH_OFF = 131072;
struct E5f {
    static constexpr bool PERM = true, AFTER_DRAIN = false, APERM = true, HAS_INIT = false;
    const float* rowsq; const float* cw; const float* cb; bf16_t* act; PG8_LAS float* X;
    __device__ __forceinline__ static f32x4 rot(f32x4 v, int) { f32x4 r;
#pragma unroll
        for (int j = 0; j < 4; ++j) r[j] = __int_as_float(__builtin_amdgcn_update_dpp(0, __float_as_int(v[j]), 0x111, 0xf, 0xf, false));
        return r; }
    __device__ __forceinline__ void operator()(f32x4 (&acc)[2][2][4][2], const pg8::Unit& u, int wr, int wc, int fr_, int fq_) const {
        int fr = fr_, fq = fq_; asm volatile("" : "+v"(fr), "+v"(fq));
        const int lane = fq * 16 + fr;
#pragma unroll
        for (int ai = 0; ai < 2; ++ai)
#pragma unroll
            for (int m = 0; m < 4; ++m) { int gr = 254 * u.pm + ai * 128 + wr * 64 + 4 * fr + m - 2; gr = gr < 0 ? 0 : (gr > SEQ - 1 ? SEQ - 1 : gr);
                const float r = rsqrtf(rowsq[gr] * (1.0f / DM) + 1e-6f);
#pragma unroll
                for (int bj = 0; bj < 2; ++bj) { acc[ai][bj][m][0] = acc[ai][bj][m][0] * r; acc[ai][bj][m][1] = acc[ai][bj][m][1] * r; }
                asm volatile("" : "+v"(acc[ai][0][m][0]), "+v"(acc[ai][0][m][1]), "+v"(acc[ai][1][m][0]), "+v"(acc[ai][1][m][1])); }
#pragma unroll
        for (int ai = 0; ai < 2; ++ai) { const int slot = 2 * ai + wr;
            if (slot < 3 && fr == 15) {
#pragma unroll
                for (int bj = 0; bj < 2; ++bj)
#pragma unroll
                    for (int rs = 0; rs < 2; ++rs) { PG8_LAS float* xp = X + ((((slot * 2 + rs) * 2 + bj) * 4 + wc) * 4 + fq) * 8; *(PG8_LAS f32x4*)xp = acc[ai][bj][2 + rs][0]; *(PG8_LAS f32x4*)(xp + 4) = acc[ai][bj][2 + rs][1]; } } }
        asm volatile("s_waitcnt lgkmcnt(0)" ::: "memory"); __builtin_amdgcn_s_barrier(); asm volatile("" ::: "memory");
        __builtin_amdgcn_s_barrier(); asm volatile("" ::: "memory");
        const int ch0 = 128 * u.pn + 32 * wc + 8 * fq; const int s1 = (lane & 48) | ((fr - 1) & 15); const bool f0 = fr == 0;
#pragma unroll
        for (int bj = 0; bj < 2; ++bj) {
#pragma unroll
            for (int n = 0; n < 2; ++n) {
                const float* wp = cw + bj * DFF + ch0 + 4 * n;
                const f32x4 w0 = *(const f32x4*)wp, w1 = *(const f32x4*)(wp + 2 * DFF), w2 = *(const f32x4*)(wp + 4 * DFF), bb = *(const f32x4*)(cb + bj * DFF + ch0 + 4 * n);
#pragma unroll
                for (int ai = 0; ai < 2; ++ai) {
                    const int slot = 2 * ai + wr - 1; f32x4 bm1 = {0.f, 0.f, 0.f, 0.f}, bm2 = {0.f, 0.f, 0.f, 0.f};
                    if (slot >= 0) { bm2 = *(const PG8_LAS f32x4*)(X + ((((slot * 2 + 0) * 2 + bj) * 4 + wc) * 4 + fq) * 8 + 4 * n); bm1 = *(const PG8_LAS f32x4*)(X + ((((slot * 2 + 1) * 2 + bj) * 4 + wc) * 4 + fq) * 8 + 4 * n); }
                    const f32x4 x0 = acc[ai][bj][0][n], x1v = acc[ai][bj][1][n], x2v = acc[ai][bj][2][n], x3v = acc[ai][bj][3][n];
                    const f32x4 r3 = rot(x3v, s1), r2 = rot(x2v, s1);
                    f32x4 o0, o1, o2, o3;
#pragma unroll
                    for (int j = 0; j < 4; ++j) {
                        const float p1 = f0 ? bm1[j] : r3[j], p2 = f0 ? bm2[j] : r2[j];
                        o0[j] = bb[j] + w2[j] * x0[j] + w1[j] * p1 + w0[j] * p2;
                        o1[j] = bb[j] + w2[j] * x1v[j] + w1[j] * x0[j] + w0[j] * p1;
                        o2[j] = bb[j] + w2[j] * x2v[j] + w1[j] * x1v[j] + w0[j] * x0[j];
                        o3[j] = bb[j] + w2[j] * x3v[j] + w1[j] * x2v[j] + w0[j] * x1v[j];
                    }
                    acc[ai][bj][0][n] = o0; acc[ai][bj][1][n] = o1; acc[ai][bj][2][n] = o2; acc[ai][bj][3][n] = o3;
                    asm volatile("" : "+v"(acc[ai][bj][0][n]), "+v"(acc[ai][bj][1][n]), "+v"(acc[ai][bj][2][n]), "+v"(acc[ai][bj][3][n]));
                    __builtin_amdgcn_sched_barrier(0);
                }
                asm volatile("" ::: "memory");
            }
        }
#pragma unroll
        for (int ai = 0; ai < 2; ++ai)
#pragma unroll
            for (int m = 0; m < 4; ++m) { const int lr = ai * 128 + wr * 64 + 4 * fr + m, gr = 254 * u.pm + lr - 2;
                if (lr >= 2 && gr < SEQ) st8(act + (size_t)gr * DFF + ch0, gelu4(acc[ai][0][m][0]) * acc[ai][1][m][0], gelu4(acc[ai][0][m][1]) * acc[ai][1][m][1]); }
    }
};
struct F6 {
    float* x1;
    __device__ __forceinline__ void operator()(int row, int col, f32x4 a, f32x4 b, int) const { float* p = x1 + (size_t)row * DM + col; *(f32x4*)p = *(const f32x4*)p + a; *(f32x4*)(p + 4) = *(const f32x4*)(p + 4) + b; }
};

#ifdef NAIVE_GLA
__device__ void gla_naive(const Params& P, float* sm) {
    if (blockIdx.x >= 4) return;
    const int h = blockIdx.x, tid = threadIdx.x;
    const bf16_t* q = (const bf16_t*)(P.ws + WS_Q); const bf16_t* k = (const bf16_t*)(P.ws + WS_K); const bf16_t* v = (const bf16_t*)(P.ws + WS_V); bf16_t* g = (bf16_t*)(P.ws + WS_G);
    const float* flow = (const float*)(P.ws + WS_FLOW); const float* wf2 = P.in[3]; const float* bf2 = P.in[4]; const float* onorm = P.in[5];
    float* al = sm; float* qs = sm + 128; float* ks = sm + 256; float* red = sm + 384;
    float St[128];
#pragma unroll
    for (int i = 0; i < 128; ++i) St[i] = 0.f;
    float wcol[16]; float bcol = 0.f;
    if (tid < 128) {
#pragma unroll
        for (int r = 0; r < 16; ++r) wcol[r] = wf2[r * 512 + h * 128 + tid];
        bcol = bf2[h * 128 + tid];
    } else {
#pragma unroll
        for (int r = 0; r < 16; ++r) wcol[r] = 0.f;
    }
    const float on = tid < 256 ? onorm[tid] : 0.f;
    for (int t = 0; t < SEQ; ++t) {
        if (tid < 128) {
            float z = bcol;
#pragma unroll
            for (int r = 0; r < 16; ++r) z += flow[(size_t)t * 16 + r] * wcol[r];
            const float ls = fminf(z, 0.f) - log1pf(__expf(-fabsf(z)));
            al[tid] = __expf(ls * (1.0f / 16.0f));
            qs[tid] = bf2f(q[(size_t)t * 512 + h * 128 + tid]) * 0.08838834764831845f;
            ks[tid] = bf2f(k[(size_t)t * 512 + h * 128 + tid]);
        }
        __syncthreads();
        float o = 0.f;
        if (tid < 256) {
            const float vv = bf2f(v[(size_t)t * 1024 + h * 256 + tid]);
#pragma unroll
            for (int i = 0; i < 128; ++i) { St[i] = al[i] * St[i] + ks[i] * vv; o += qs[i] * St[i]; }
        }
        const float s2 = wave_sum(o * o);
        if ((tid & 63) == 0) red[tid >> 6] = s2;
        __syncthreads();
        if (tid < 256) {
            const float tot = red[0] + red[1] + red[2] + red[3];
            const float rr = rsqrtf(tot * (1.0f / 256.0f) + 1e-6f);
            const size_t gi = (size_t)t * 1024 + h * 256 + tid;
            const float gv = bf2f(g[gi]);
            const float res = o * rr * on * (gv * sigm(gv));
            g[gi] = (bf16_t)(pg8::cvt_pk_bf16(res, 0.f) & 0xffffu);
        }
    }
}
#endif
#ifdef NAIVE_LRU
__device__ void lru_naive(const Params& P, float* sm) {
    if (blockIdx.x >= 8) return;
    const int j = blockIdx.x, tid = threadIdx.x; const bool act = tid < 168; const int ch = j * 168 + (act ? tid : 0);
    const bf16_t* xl = (const bf16_t*)(P.ws + WS_XL); const bf16_t* gg = (const bf16_t*)(P.ws + WS_GG); bf16_t* hb = (bf16_t*)(P.ws + WS_HB);
    const float* cw = P.in[7]; const float* cb = P.in[8]; const float* wa = P.in[9] + (size_t)j * 168 * 168; const float* ba = P.in[10]; const float* wx = P.in[11] + (size_t)j * 168 * 168; const float* bx = P.in[12]; const float* ap = P.in[13];
    const float w0 = cw[ch], w1 = cw[LW + ch], w2 = cw[2 * LW + ch], w3 = cw[3 * LW + ch], b0 = cb[ch], bav = ba[ch], bxv = bx[ch];
    const float apv = ap[ch]; const float sp = fmaxf(apv, 0.f) + log1pf(__expf(-fabsf(apv)));
    float x3 = 0.f, x2 = 0.f, x1 = 0.f, hs = 0.f;
    float* xcs = sm;
    for (int t = 0; t < SEQ; ++t) {
        float xc = 0.f;
        if (act) { const float xv = bf2f(xl[(size_t)t * LW + ch]); xc = b0 + w0 * x3 + w1 * x2 + w2 * x1 + w3 * xv; x3 = x2; x2 = x1; x1 = xv; xcs[tid] = xc; }
        __syncthreads();
        if (act) {
            float ra = bav, ri = bxv;
            for (int c = 0; c < 168; ++c) { const float xv = xcs[c]; ra += xv * wa[c * 168 + tid]; ri += xv * wx[c * 168 + tid]; }
            const float r = sigm(ra), ig = sigm(ri);
            const float la = -8.0f * r * sp; const float a = __expf(la);
            const float uu = sqrtf(-expm1f(2.0f * la)) * (ig * xc);
            hs = a * hs + uu;
            const float res = hs * bf2f(gg[(size_t)t * LW + ch]);
            hb[(size_t)t * LWP + ch] = (bf16_t)(pg8::cvt_pk_bf16(res, 0.f) & 0xffffu);
        } else if (tid < 176) { hb[(size_t)t * LWP + LW + j * 8 + (tid - 168)] = 0; }
        __syncthreads();
    }
}
#endif
typedef pg8::bf16x8 bf16x8;
typedef unsigned u32x4_t __attribute__((ext_vector_type(4)));
typedef unsigned u32x2_t __attribute__((ext_vector_type(2)));
#define LAS PG8_LAS
constexpr int GL_QS = 0, GL_KT = 17408, GL_KST = 34816, GL_VT = 53248, GL_AM = 90112, GL_DEC = 99328, GL_RSQ = 99840, GL_WF = 101888, GL_BF = 110080;
constexpr int RS128 = 272, RS64 = 144;
constexpr size_t WS_GATEW = 24 * MiB + 768 * 1024;
constexpr size_t WS_DSEG = 25 * MiB + 896 * 1024;
constexpr size_t OUT_L = 0;
constexpr size_t OUT_SUMS = 0;
constexpr size_t OUT_CARRY = 4 * MiB;

__device__ __forceinline__ unsigned short f2bf(float x) { return (unsigned short)(pg8::cvt_pk_bf16(x, 0.f) & 0xffffu); }
__device__ __forceinline__ bf16x8 pack8(f32x4 a, f32x4 b) { u32x4_t w; w[0] = pg8::cvt_pk_bf16(a[0], a[1]); w[1] = pg8::cvt_pk_bf16(a[2], a[3]); w[2] = pg8::cvt_pk_bf16(b[0], b[1]); w[3] = pg8::cvt_pk_bf16(b[2], b[3]); return __builtin_bit_cast(bf16x8, w); }
#define MFMA16(a, b, c) __builtin_amdgcn_mfma_f32_16x16x32_bf16((a), (b), (c), 0, 0, 0)

template <bool OUT>
__device__ void gla_pass(const Params& P, LAS unsigned char* lds) {
    const int tid = threadIdx.x, lane = tid & 63, w = __builtin_amdgcn_readfirstlane(tid >> 6), fr = lane & 15, fq = lane >> 4;
    const bf16_t* q = (const bf16_t*)(P.ws + WS_Q); const bf16_t* k = (const bf16_t*)(P.ws + WS_K); const bf16_t* v = (const bf16_t*)(P.ws + WS_V); bf16_t* g = (bf16_t*)(P.ws + WS_G);
    const float* flow = (const float*)(P.ws + WS_FLOW); const float* wf2 = P.in[3]; const float* bf2 = P.in[4]; const float* onorm = P.in[5];
    float* L = (float*)((unsigned char*)P.out + OUT_L); float* Dg = (float*)(P.ws + WS_DSEG);
    LAS float* dec = (LAS float*)(lds + GL_DEC); LAS float* rsq = (LAS float*)(lds + GL_RSQ);
    for (int item = blockIdx.x; item < 256; item += gridDim.x) {
        const int s = item >> 2, h = item & 3;
        f32x4 Sa[8][2];
        float* Lp = L + (size_t)(s * 4 + h) * 32768 + w * 4096;
#pragma unroll
        for (int mt = 0; mt < 8; ++mt)
#pragma unroll
            for (int ni = 0; ni < 2; ++ni) Sa[mt][ni] = OUT ? *(const f32x4*)(Lp + ((mt * 2 + ni) * 64 + lane) * 4) : (f32x4){0.f, 0.f, 0.f, 0.f};
        float blsum[16];
#pragma unroll
        for (int i = 0; i < 16; ++i) blsum[i] = 0.f;
        for (int e = tid; e < 2048; e += 512) { const int r = e >> 7, kc = e & 127; *(LAS float*)(lds + GL_WF + (kc * 16 + r) * 4) = wf2[r * 512 + h * 128 + kc]; }
        if (tid < 128) *(LAS float*)(lds + GL_BF + tid * 4) = bf2[h * 128 + tid];
        __syncthreads();
        f32x4 flp[4]; uint4 qap, qbp, kap, kbp;
        if constexpr (!OUT) { const size_t tp = (size_t)(s * 256 + lane);
#pragma unroll
          for (int r4 = 0; r4 < 4; ++r4) flp[r4] = *(const f32x4*)(flow + tp * 16 + r4 * 4);
          qap = *(const uint4*)(q + tp * 512 + h * 128 + 16 * w); qbp = *(const uint4*)(q + tp * 512 + h * 128 + 16 * w + 8);
          kap = *(const uint4*)(k + tp * 512 + h * 128 + 16 * w); kbp = *(const uint4*)(k + tp * 512 + h * 128 + 16 * w + 8); }
        for (int ch = 0; ch < 4; ++ch) {
            const int t0 = s * 256 + ch * 64; const size_t t = (size_t)(t0 + lane);
            uint4 vpre[4];
#pragma unroll
            for (int i = 0; i < 4; ++i) vpre[i] = *(const uint4*)(v + t * 1024 + h * 256 + 8 * (w + 8 * i));
            uint2 gpre[4][2];
            if (OUT) {
#pragma unroll
                for (int nt = 0; nt < 4; ++nt)
#pragma unroll
                    for (int mi = 0; mi < 2; ++mi) gpre[nt][mi] = *(const uint2*)(g + (size_t)(t0 + 16 * nt + fr) * 1024 + h * 256 + 16 * (2 * w + mi) + 4 * fq);
            }
            {
                float fl[16]; uint4 qa, qb, ka, kb;
                if constexpr (OUT) {
#pragma unroll
                    for (int r4 = 0; r4 < 4; ++r4) { const f32x4 x = *(const f32x4*)(flow + t * 16 + r4 * 4); fl[r4 * 4] = x[0]; fl[r4 * 4 + 1] = x[1]; fl[r4 * 4 + 2] = x[2]; fl[r4 * 4 + 3] = x[3]; }
                    qa = *(const uint4*)(q + t * 512 + h * 128 + 16 * w); qb = *(const uint4*)(q + t * 512 + h * 128 + 16 * w + 8);
                    ka = *(const uint4*)(k + t * 512 + h * 128 + 16 * w); kb = *(const uint4*)(k + t * 512 + h * 128 + 16 * w + 8);
                } else {
#pragma unroll
                    for (int r4 = 0; r4 < 4; ++r4) { const f32x4 x = flp[r4]; fl[r4 * 4] = x[0]; fl[r4 * 4 + 1] = x[1]; fl[r4 * 4 + 2] = x[2]; fl[r4 * 4 + 3] = x[3]; }
                    qa = qap; qb = qbp; ka = kap; kb = kbp;
                    if (ch < 3) { const size_t tn = t + 64;
#pragma unroll
                        for (int r4 = 0; r4 < 4; ++r4) flp[r4] = *(const f32x4*)(flow + tn * 16 + r4 * 4);
                        qap = *(const uint4*)(q + tn * 512 + h * 128 + 16 * w); qbp = *(const uint4*)(q + tn * 512 + h * 128 + 16 * w + 8);
                        kap = *(const uint4*)(k + tn * 512 + h * 128 + 16 * w); kbp = *(const uint4*)(k + tn * 512 + h * 128 + 16 * w + 8); }
                }
                const unsigned qw[8] = {qa.x, qa.y, qa.z, qa.w, qb.x, qb.y, qb.z, qb.w}, kw[8] = {ka.x, ka.y, ka.z, ka.w, kb.x, kb.y, kb.z, kb.w};
                float qt[16], kt[16];
#pragma unroll
                for (int i = 0; i < 16; ++i) {
                    float z = *(const LAS float*)(lds + GL_BF + (16 * w + i) * 4);
#pragma unroll
                    for (int r4 = 0; r4 < 4; ++r4) { const f32x4 wv = *(const LAS f32x4*)(lds + GL_WF + ((16 * w + i) * 16 + r4 * 4) * 4); z += fl[r4 * 4] * wv[0] + fl[r4 * 4 + 1] * wv[1] + fl[r4 * 4 + 2] * wv[2] + fl[r4 * 4 + 3] * wv[3]; }
                    float b = (fminf(z, 0.f) - __logf(1.0f + __expf(-fabsf(z)))) * (1.0f / 16.0f);
                    b += __int_as_float(__builtin_amdgcn_update_dpp(0, __float_as_int(b), 0x111, 0xf, 0xf, false));
                    b += __int_as_float(__builtin_amdgcn_update_dpp(0, __float_as_int(b), 0x112, 0xf, 0xf, false));
                    b += __int_as_float(__builtin_amdgcn_update_dpp(0, __float_as_int(b), 0x114, 0xf, 0xf, false));
                    b += __int_as_float(__builtin_amdgcn_update_dpp(0, __float_as_int(b), 0x118, 0xf, 0xf, false));
                    { const float t0r = __int_as_float(__builtin_amdgcn_readlane(__float_as_int(b), 15)), t1r = __int_as_float(__builtin_amdgcn_readlane(__float_as_int(b), 31)), t2r = __int_as_float(__builtin_amdgcn_readlane(__float_as_int(b), 47));
                      b += fq == 0 ? 0.f : (fq == 1 ? t0r : (fq == 2 ? t0r + t1r : t0r + t1r + t2r)); }
                    const float bl = __int_as_float(__builtin_amdgcn_readlane(__float_as_int(b), 63));
                    const float qv = (i & 1) ? __uint_as_float(qw[i >> 1] & 0xffff0000u) : __uint_as_float(qw[i >> 1] << 16);
                    const float kv = (i & 1) ? __uint_as_float(kw[i >> 1] & 0xffff0000u) : __uint_as_float(kw[i >> 1] << 16);
                    qt[i] = qv * __expf(b) * 0.08838834764831845f; kt[i] = kv * __expf(-b);
                    *(LAS unsigned short*)(lds + GL_KST + (16 * w + i) * RS64 + lane * 2) = f2bf(kv * __expf(bl - b));
                    if (lane == 63) dec[16 * w + i] = __expf(bl);
                    blsum[i] += bl;
                }
                u32x4_t p0, p1;
#pragma unroll
                for (int i = 0; i < 4; ++i) { p0[i] = pg8::cvt_pk_bf16(qt[2 * i], qt[2 * i + 1]); p1[i] = pg8::cvt_pk_bf16(qt[8 + 2 * i], qt[8 + 2 * i + 1]); }
                *(LAS u32x4_t*)(lds + GL_QS + lane * RS128 + 32 * w) = p0; *(LAS u32x4_t*)(lds + GL_QS + lane * RS128 + 32 * w + 16) = p1;
#pragma unroll
                for (int i = 0; i < 4; ++i) { p0[i] = pg8::cvt_pk_bf16(kt[2 * i], kt[2 * i + 1]); p1[i] = pg8::cvt_pk_bf16(kt[8 + 2 * i], kt[8 + 2 * i + 1]); }
                *(LAS u32x4_t*)(lds + GL_KT + lane * RS128 + 32 * w) = p0; *(LAS u32x4_t*)(lds + GL_KT + lane * RS128 + 32 * w + 16) = p1;
            }
#pragma unroll
            for (int i = 0; i < 4; ++i) {
                const int cgp = w + 8 * i; const uint4 vv = vpre[i]; const unsigned vw[4] = {vv.x, vv.y, vv.z, vv.w};
#pragma unroll
                for (int e = 0; e < 8; ++e) *(LAS unsigned short*)(lds + GL_VT + (8 * cgp + e) * RS64 + lane * 2) = (unsigned short)((e & 1) ? (vw[e >> 1] >> 16) : (vw[e >> 1] & 0xffffu));
            }
            __syncthreads();
            if (OUT) {
                {
                    const int nt = w & 3;
#pragma unroll
                    for (int mm = 0; mm < 2; ++mm) {
                        const int mt = 2 * (w >> 2) + mm; f32x4 acc = {0.f, 0.f, 0.f, 0.f};
                        if (mt <= nt) {
#pragma unroll
                            for (int kk = 0; kk < 4; ++kk) { const bf16x8 a = *(const LAS bf16x8*)(lds + GL_KT + (16 * mt + fr) * RS128 + (32 * kk + 8 * fq) * 2); const bf16x8 b = *(const LAS bf16x8*)(lds + GL_QS + (16 * nt + fr) * RS128 + (32 * kk + 8 * fq) * 2); acc = MFMA16(a, b, acc); }
                        }
#pragma unroll
                        for (int j = 0; j < 4; ++j) if (16 * mt + 4 * fq + j > 16 * nt + fr) acc[j] = 0.f;
                        u32x2_t pw; pw[0] = pg8::cvt_pk_bf16(acc[0], acc[1]); pw[1] = pg8::cvt_pk_bf16(acc[2], acc[3]);
                        *(LAS u32x2_t*)(lds + GL_AM + (16 * nt + fr) * RS64 + (16 * mt + 4 * fq) * 2) = pw;
                    }
                }
                __syncthreads();
                f32x4 oT[2][4];
#pragma unroll
                for (int mi = 0; mi < 2; ++mi)
#pragma unroll
                    for (int nt = 0; nt < 4; ++nt) oT[mi][nt] = (f32x4){0.f, 0.f, 0.f, 0.f};
#pragma unroll
                for (int kk = 0; kk < 2; ++kk) {
                    bf16x8 bfr[4];
#pragma unroll
                    for (int nt = 0; nt < 4; ++nt) bfr[nt] = *(const LAS bf16x8*)(lds + GL_AM + (16 * nt + fr) * RS64 + (32 * kk + 8 * fq) * 2);
#pragma unroll
                    for (int mi = 0; mi < 2; ++mi) { const bf16x8 a = *(const LAS bf16x8*)(lds + GL_VT + (16 * (2 * w + mi) + fr) * RS64 + (32 * kk + 8 * fq) * 2);
#pragma unroll
                        for (int nt = 0; nt < 4; ++nt) oT[mi][nt] = MFMA16(a, bfr[nt], oT[mi][nt]); }
                }
#pragma unroll
                for (int kk = 0; kk < 4; ++kk) {
                    bf16x8 bfr[4];
#pragma unroll
                    for (int nt = 0; nt < 4; ++nt) { const u32x2_t lo = *(const LAS u32x2_t*)(lds + GL_QS + (16 * nt + fr) * RS128 + (32 * kk + 4 * fq) * 2), hi = *(const LAS u32x2_t*)(lds + GL_QS + (16 * nt + fr) * RS128 + (32 * kk + 16 + 4 * fq) * 2);
                        u32x4_t wv; wv[0] = lo[0]; wv[1] = lo[1]; wv[2] = hi[0]; wv[3] = hi[1]; bfr[nt] = __builtin_bit_cast(bf16x8, wv); }
#pragma unroll
                    for (int mi = 0; mi < 2; ++mi) { const bf16x8 a = pack8(Sa[2 * kk][mi], Sa[2 * kk + 1][mi]);
#pragma unroll
                        for (int nt = 0; nt < 4; ++nt) oT[mi][nt] = MFMA16(a, bfr[nt], oT[mi][nt]); }
                }
#pragma unroll
                for (int nt = 0; nt < 4; ++nt) {
                    float ps = 0.f;
#pragma unroll
                    for (int mi = 0; mi < 2; ++mi)
#pragma unroll
                        for (int j = 0; j < 4; ++j) ps += oT[mi][nt][j] * oT[mi][nt][j];
                    ps += __shfl_xor(ps, 16); ps += __shfl_xor(ps, 32);
                    if (fq == 0) rsq[(16 * nt + fr) * 8 + w] = ps;
                }
                __syncthreads();
#pragma unroll
                for (int nt = 0; nt < 4; ++nt) {
                    const f32x4 r0 = *(const LAS f32x4*)(rsq + (16 * nt + fr) * 8), r1 = *(const LAS f32x4*)(rsq + (16 * nt + fr) * 8 + 4);
                    const float tot = (r0[0] + r0[1]) + (r0[2] + r0[3]) + (r1[0] + r1[1]) + (r1[2] + r1[3]);
                    const float rstd = rsqrtf(tot * (1.0f / 256.0f) + 1e-6f);
#pragma unroll
                    for (int mi = 0; mi < 2; ++mi) {
                        const int c = 16 * (2 * w + mi) + 4 * fq; const size_t gi = (size_t)(t0 + 16 * nt + fr) * 1024 + h * 256 + c;
                        f32x4 gv; { const uint2 gw2 = gpre[nt][mi]; gv[0] = __uint_as_float(gw2.x << 16); gv[1] = __uint_as_float(gw2.x & 0xffff0000u); gv[2] = __uint_as_float(gw2.y << 16); gv[3] = __uint_as_float(gw2.y & 0xffff0000u); }
                        const f32x4 on = *(const f32x4*)(onorm + c); f32x4 res;
#pragma unroll
                        for (int j = 0; j < 4; ++j) res[j] = oT[mi][nt][j] * rstd * on[j] * (gv[j] * sigm(gv[j]));
                        st4(g + gi, res);
                    }
                }
            }
#pragma unroll
            for (int mt = 0; mt < 8; ++mt) { const f32x4 dv = *(const LAS f32x4*)(dec + 16 * mt + 4 * fq);
#pragma unroll
                for (int ni = 0; ni < 2; ++ni) Sa[mt][ni] = Sa[mt][ni] * dv; }
#pragma unroll
            for (int kk = 0; kk < 2; ++kk) {
                bf16x8 bfr[2];
#pragma unroll
                for (int ni = 0; ni < 2; ++ni) bfr[ni] = *(const LAS bf16x8*)(lds + GL_VT + (16 * (2 * w + ni) + fr) * RS64 + (32 * kk + 8 * fq) * 2);
#pragma unroll
                for (int mt = 0; mt < 8; ++mt) { const bf16x8 a = *(const LAS bf16x8*)(lds + GL_KST + (16 * mt + fr) * RS64 + (32 * kk + 8 * fq) * 2);
#pragma unroll
                    for (int ni = 0; ni < 2; ++ni) Sa[mt][ni] = MFMA16(a, bfr[ni], Sa[mt][ni]); }
            }
            __syncthreads();
        }
        if (!OUT) {
#pragma unroll
            for (int mt = 0; mt < 8; ++mt)
#pragma unroll
                for (int ni = 0; ni < 2; ++ni) *(f32x4*)(Lp + ((mt * 2 + ni) * 64 + lane) * 4) = Sa[mt][ni];
            if (lane == 0) {
#pragma unroll
                for (int i = 0; i < 16; ++i) Dg[(s * 4 + h) * 128 + 16 * w + i] = __expf(blsum[i]);
            }
        }
    }
}
__device__ void gla_scan(const Params& P) {
    float* L = (float*)((unsigned char*)P.out + OUT_L); const float* Dg = (const float*)(P.ws + WS_DSEG);
    for (int e = blockIdx.x * 512 + threadIdx.x; e < 131072; e += gridDim.x * 512) {
        const int h = e >> 15, r = e & 32767, mt = (r >> 9) & 7, ln = (r >> 2) & 63, j = r & 3; const int kk = 16 * mt + 4 * (ln >> 4) + j;
        float st = 0.f;
        for (int s0 = 0; s0 < 64; s0 += 32) {
            float tmp[32], dd[32];
#pragma unroll
            for (int i = 0; i < 32; ++i) { tmp[i] = L[(size_t)((s0 + i) * 4 + h) * 32768 + r]; dd[i] = Dg[((s0 + i) * 4 + h) * 128 + kk]; }
#pragma unroll
            for (int i = 0; i < 32; ++i) { L[(size_t)((s0 + i) * 4 + h) * 32768 + r] = st; st = dd[i] * st + tmp[i]; }
        }
    }
}

constexpr int LR_XCB = 0, LR_XCF = 25600, LR_AA = 71680, LR_PE = 117760, LR_CW = 121792, LR_XN = 127488;
constexpr int XCB_RS = 400, XCF_RS = 720;
constexpr size_t WS_SP = 255 * MiB + 64 * 1024;
__device__ void lru_pass1(const Params& P, LAS unsigned char* lds) {
    const int tid = threadIdx.x, lane = tid & 63, w = __builtin_amdgcn_readfirstlane(tid >> 6), fr = lane & 15, fq = lane >> 4;
    const bf16_t* xl = (const bf16_t*)(P.ws + WS_XL); bf16_t* gg = (bf16_t*)(P.ws + WS_GG); bf16_t* a1 = (bf16_t*)(P.ws + WS_HB);
    const bf16_t* gw = (const bf16_t*)(P.ws + WS_GATEW); float* sums = (float*)((unsigned char*)P.out + OUT_SUMS);
    const float* cw = P.in[7]; const float* cb = P.in[8]; const float* ba = P.in[10]; const float* bx = P.in[12]; const float* spp = (const float*)(P.ws + WS_SP);
    LAS float* CW = (LAS float*)(lds + LR_CW);
    int jb_lds = -1;
    auto dma_x = [&](int it_) {
        const int t0n = (it_ >> 3) * 64, jbn = it_ & 7;
#pragma unroll
        for (int i = 0; i < 3; ++i) {
            int p = (i * 8 + w) * 64 + lane; p = p < 67 * 21 ? p : 67 * 21 - 1;
            const int row = p / 21, c16 = p - row * 21; int tg = t0n - 3 + row; tg = tg < 0 ? 0 : tg;
            __builtin_amdgcn_global_load_lds((const unsigned*)(xl + (size_t)tg * LW + jbn * 168 + c16 * 8), (LAS unsigned*)(lds + LR_XN + (i * 8 + w) * 1024), 16, 0, 0);
        }
    };
    if ((int)blockIdx.x < 2048) dma_x((int)blockIdx.x);
    for (int item = blockIdx.x; item < 2048; item += gridDim.x) {
        const int tile = item >> 3, jb = item & 7, t0 = tile * 64;
        if (jb != jb_lds) {
            __syncthreads();
            for (int e = tid; e < 8 * 168; e += 512) { const int r = e / 168, c = e - r * 168, chn = jb * 168 + c;
                CW[r * 176 + c] = r < 4 ? cw[r * LW + chn] : (r == 4 ? cb[chn] : (r == 5 ? ba[chn] : (r == 6 ? bx[chn] : spp[chn]))); }
            jb_lds = jb;
            __syncthreads();
        }
        const bf16_t* waT = gw + (size_t)(jb * 2) * 192 * 192; const bf16_t* wxT = waT + 192 * 192;
        bf16x8 aA[6], aX[6];
        { const int m = w >> 1;
#pragma unroll
          for (int kk = 0; kk < 6; ++kk) { aA[kk] = *(const bf16x8*)(waT + (16 * m + fr) * 192 + 32 * kk + 8 * fq); aX[kk] = *(const bf16x8*)(wxT + (16 * m + fr) * 192 + 32 * kk + 8 * fq); } }
        uint4 ggpre[3];
#pragma unroll
        for (int it = 0; it < 3; ++it) { const int wi = tid + 512 * it; const int tt = wi / 21, c0 = (wi - tt * 21) * 8; ggpre[it] = wi < 64 * 21 ? *(const uint4*)(gg + (size_t)(t0 + tt) * LW + jb * 168 + c0) : make_uint4(0u, 0u, 0u, 0u); }
        asm volatile("s_waitcnt vmcnt(0)" ::: "memory"); __syncthreads();
        for (int wi = tid; wi < 64 * 24; wi += 512) {
            const int tt = wi / 24, cg8 = wi - tt * 24, c0 = cg8 * 8;
            if (cg8 < 21) {
                const int chn = jb * 168 + c0; f32x4 xa = *(const LAS f32x4*)(CW + 4 * 176 + c0), xb = *(const LAS f32x4*)(CW + 4 * 176 + c0 + 4);
#pragma unroll
                for (int d = 0; d < 4; ++d) {
                    const int tg = t0 + tt - 3 + d;
                    if (tg >= 0) { const u32x4_t xq = *(const LAS u32x4_t*)(lds + LR_XN + ((tt + d) * 21 + cg8) * 16); const uint4 xv = make_uint4(xq[0], xq[1], xq[2], xq[3]); const f32x4 wa4 = *(const LAS f32x4*)(CW + d * 176 + c0), wb4 = *(const LAS f32x4*)(CW + d * 176 + c0 + 4);
                        xa[0] += wa4[0] * __uint_as_float(xv.x << 16); xa[1] += wa4[1] * __uint_as_float(xv.x & 0xffff0000u); xa[2] += wa4[2] * __uint_as_float(xv.y << 16); xa[3] += wa4[3] * __uint_as_float(xv.y & 0xffff0000u);
                        xb[0] += wb4[0] * __uint_as_float(xv.z << 16); xb[1] += wb4[1] * __uint_as_float(xv.z & 0xffff0000u); xb[2] += wb4[2] * __uint_as_float(xv.w << 16); xb[3] += wb4[3] * __uint_as_float(xv.w & 0xffff0000u); }
                }
                u32x4_t pw; pw[0] = pg8::cvt_pk_bf16(xa[0], xa[1]); pw[1] = pg8::cvt_pk_bf16(xa[2], xa[3]); pw[2] = pg8::cvt_pk_bf16(xb[0], xb[1]); pw[3] = pg8::cvt_pk_bf16(xb[2], xb[3]);
                *(LAS u32x4_t*)(lds + LR_XCB + tt * XCB_RS + c0 * 2) = pw;
                *(LAS f32x4*)(lds + LR_XCF + tt * XCF_RS + c0 * 4) = xa; *(LAS f32x4*)(lds + LR_XCF + tt * XCF_RS + c0 * 4 + 16) = xb;
            } else { *(LAS u32x4_t*)(lds + LR_XCB + tt * XCB_RS + c0 * 2) = (u32x4_t){0u, 0u, 0u, 0u}; }
        }
        __syncthreads();
        if (item + (int)gridDim.x < 2048) dma_x(item + (int)gridDim.x);
        for (int un = w; un < 22; un += 8) {
            const int m = un >> 1, nh = un & 1; const int c0 = 16 * m + 4 * fq; const bool cv = c0 < 168; const int chn = jb * 168 + (cv ? c0 : 0);
            const int c0s = cv ? c0 : 0; const f32x4 bav = *(const LAS f32x4*)(CW + 5 * 176 + c0s), bxv = *(const LAS f32x4*)(CW + 6 * 176 + c0s), spv = *(const LAS f32x4*)(CW + 7 * 176 + c0s);
            f32x4 accA[2], accX[2];
#pragma unroll
            for (int nn = 0; nn < 2; ++nn) { accA[nn] = (f32x4){0.f, 0.f, 0.f, 0.f}; accX[nn] = accA[nn]; }
#pragma unroll
            for (int kk = 0; kk < 6; ++kk)
#pragma unroll
                for (int nn = 0; nn < 2; ++nn) { const bf16x8 bfr = *(const LAS bf16x8*)(lds + LR_XCB + (16 * (2 * nh + nn) + fr) * XCB_RS + (32 * kk + 8 * fq) * 2); accA[nn] = MFMA16(aA[kk], bfr, accA[nn]); accX[nn] = MFMA16(aX[kk], bfr, accX[nn]); }
            if (un + 8 < 22) { const int m2 = (un + 8) >> 1;
#pragma unroll
                for (int kk = 0; kk < 6; ++kk) { aA[kk] = *(const bf16x8*)(waT + (16 * m2 + fr) * 192 + 32 * kk + 8 * fq); aX[kk] = *(const bf16x8*)(wxT + (16 * m2 + fr) * 192 + 32 * kk + 8 * fq); } }
            if (cv) {
#pragma unroll
                for (int nn = 0; nn < 2; ++nn) {
                    const int tt = 16 * (2 * nh + nn) + fr; const f32x4 xcv = *(const LAS f32x4*)(lds + LR_XCF + tt * XCF_RS + c0 * 4); f32x4 av, uv;
#pragma unroll
                    for (int jj = 0; jj < 4; ++jj) {
                        const float r = __builtin_amdgcn_rcpf(1.0f + __expf(-(accA[nn][jj] + bav[jj]))), ig = __builtin_amdgcn_rcpf(1.0f + __expf(-(accX[nn][jj] + bxv[jj])));
                        const float a = __expf(-8.0f * r * spv[jj]); av[jj] = a; uv[jj] = sqrtf(fmaxf(1.0f - a * a, 0.f)) * (ig * xcv[jj]);
                    }
                    *(LAS f32x4*)(lds + LR_AA + tt * XCF_RS + c0 * 4) = av; *(LAS f32x4*)(lds + LR_XCF + tt * XCF_RS + c0 * 4) = uv;
                }
            }
        }
        __syncthreads();
        LAS float* PE = (LAS float*)(lds + LR_PE); LAS float* HE = PE + 3 * 168;
        if (tid < 504) {
            const int part = tid / 168, c = tid - part * 168, tb = part * 22, nst = part == 2 ? 20 : 22; float hs = 0.f, pp = 1.f;
            LAS unsigned char* pa0 = lds + LR_AA + tb * XCF_RS + c * 4; LAS unsigned char* pu0 = lds + LR_XCF + tb * XCF_RS + c * 4;
            float av[22], uv[22];
#pragma unroll
            for (int i = 0; i < 22; ++i) if (i < nst) { av[i] = *(const LAS float*)(pa0 + i * XCF_RS); uv[i] = *(const LAS float*)(pu0 + i * XCF_RS); }
#pragma unroll
            for (int i = 0; i < 22; ++i) if (i < nst) { hs = av[i] * hs + uv[i]; pp *= av[i]; uv[i] = hs; av[i] = pp; }
#pragma unroll
            for (int i = 0; i < 22; ++i) if (i < nst) { *(LAS float*)(pu0 + i * XCF_RS) = uv[i]; *(LAS float*)(pa0 + i * XCF_RS) = av[i]; }
            PE[tid] = pp; HE[tid] = hs;
        }
        __syncthreads();
#pragma unroll
        for (int it = 0; it < 3; ++it) {
            const int wi = tid + 512 * it; if (wi >= 64 * 21) break;
            const int tt = wi / 21, c0 = (wi - tt * 21) * 8; const int part = tt >= 44 ? 2 : (tt >= 22 ? 1 : 0);
            float hl[8], pl[8], chh[8], cpp[8];
            { const f32x4 x0 = *(const LAS f32x4*)(lds + LR_XCF + tt * XCF_RS + c0 * 4), x1 = *(const LAS f32x4*)(lds + LR_XCF + tt * XCF_RS + c0 * 4 + 16);
              const f32x4 y0 = *(const LAS f32x4*)(lds + LR_AA + tt * XCF_RS + c0 * 4), y1 = *(const LAS f32x4*)(lds + LR_AA + tt * XCF_RS + c0 * 4 + 16);
#pragma unroll
              for (int i = 0; i < 4; ++i) { hl[i] = x0[i]; hl[4 + i] = x1[i]; pl[i] = y0[i]; pl[4 + i] = y1[i]; } }
#pragma unroll
            for (int i = 0; i < 8; ++i) {
                const float p0 = PE[c0 + i], h0 = HE[c0 + i], p1 = PE[168 + c0 + i], h1v = HE[168 + c0 + i];
                chh[i] = part == 0 ? 0.f : (part == 1 ? h0 : p1 * h0 + h1v); cpp[i] = part == 0 ? 1.f : (part == 1 ? p0 : p0 * p1);
            }
            const int chn = jb * 168 + c0; const size_t gi = (size_t)(t0 + tt) * LW + chn;
            const uint4 gv = ggpre[it]; const unsigned gw4[4] = {gv.x, gv.y, gv.z, gv.w}; unsigned o1[4], o2[4];
#pragma unroll
            for (int i = 0; i < 4; ++i) {
                const float g0 = __uint_as_float(gw4[i] << 16), g1 = __uint_as_float(gw4[i] & 0xffff0000u);
                o1[i] = pg8::cvt_pk_bf16((hl[2 * i] + pl[2 * i] * chh[2 * i]) * g0, (hl[2 * i + 1] + pl[2 * i + 1] * chh[2 * i + 1]) * g1);
                o2[i] = pg8::cvt_pk_bf16(pl[2 * i] * cpp[2 * i] * g0, pl[2 * i + 1] * cpp[2 * i + 1] * g1);
            }
            *(uint4*)(a1 + (size_t)(t0 + tt) * LWP + chn) = make_uint4(o1[0], o1[1], o1[2], o1[3]);
            *(uint4*)(gg + gi) = make_uint4(o2[0], o2[1], o2[2], o2[3]);
        }
        if (tid < 168) {
            const float p0 = PE[tid], h0 = HE[tid], p1 = PE[168 + tid], h1v = HE[168 + tid], p2 = PE[336 + tid], h2 = HE[336 + tid];
            const int chn = jb * 168 + tid;
            sums[((size_t)chn * 256 + tile) * 2] = p0 * p1 * p2; sums[((size_t)chn * 256 + tile) * 2 + 1] = (h0 * p1 + h1v) * p2 + h2;
        }
        __syncthreads();
    }
}
__device__ void lru_pass2(const Params& P) {
    const int lane = threadIdx.x & 63, w = threadIdx.x >> 6;
    const float* sums = (const float*)((unsigned char*)P.out + OUT_SUMS); float* carry = (float*)((unsigned char*)P.out + OUT_CARRY);
    for (int chn = blockIdx.x * 8 + w; chn < LW; chn += gridDim.x * 8) {
        const f32x4 s0 = *(const f32x4*)(sums + ((size_t)chn * 256 + 4 * lane) * 2), s1 = *(const f32x4*)(sums + ((size_t)chn * 256 + 4 * lane) * 2 + 4);
        const float p[4] = {s0[0], s0[2], s1[0], s1[2]}, hh[4] = {s0[1], s0[3], s1[1], s1[3]};
        float Pa = 1.f, Ha = 0.f;
#pragma unroll
        for (int i = 0; i < 4; ++i) { Ha = p[i] * Ha + hh[i]; Pa *= p[i]; }
#pragma unroll
        for (int d = 1; d < 64; d <<= 1) { const float Pp = __shfl_up(Pa, d), Hp = __shfl_up(Ha, d); if (lane >= d) { Ha = Pa * Hp + Ha; Pa = Pa * Pp; } }
        float c = __shfl_up(Ha, 1); if (lane == 0) c = 0.f;
#pragma unroll
        for (int i = 0; i < 4; ++i) { carry[(size_t)(4 * lane + i) * LW + chn] = c; c = p[i] * c + hh[i]; }
    }
}
__device__ void lru_pass3(const Params& P) {
    bf16_t* a1 = (bf16_t*)(P.ws + WS_HB); const bf16_t* a2 = (const bf16_t*)(P.ws + WS_GG); const float* carry = (const float*)((unsigned char*)P.out + OUT_CARRY);
    const int nthr = gridDim.x * blockDim.x;
    for (int idx = blockIdx.x * blockDim.x + threadIdx.x; idx < SEQ * 176; idx += nthr) {
        const int t = idx / 176, g8 = idx % 176, c0 = g8 * 8; bf16_t* dst = a1 + (size_t)t * LWP + c0;
        if (g8 >= 168) { *(uint4*)dst = make_uint4(0u, 0u, 0u, 0u); continue; }
        const uint4 x1 = *(const uint4*)dst, x2 = *(const uint4*)(a2 + (size_t)t * LW + c0);
        const f32x4 ca = *(const f32x4*)(carry + (size_t)(t >> 6) * LW + c0), cbv = *(const f32x4*)(carry + (size_t)(t >> 6) * LW + c0 + 4);
        const unsigned w1[4] = {x1.x, x1.y, x1.z, x1.w}, w2[4] = {x2.x, x2.y, x2.z, x2.w}; const float cc[8] = {ca[0], ca[1], ca[2], ca[3], cbv[0], cbv[1], cbv[2], cbv[3]};
        unsigned o[4];
#pragma unroll
        for (int i = 0; i < 4; ++i) {
            const float lo = __uint_as_float(w1[i] << 16) + __uint_as_float(w2[i] << 16) * cc[2 * i], hi = __uint_as_float(w1[i] & 0xffff0000u) + __uint_as_float(w2[i] & 0xffff0000u) * cc[2 * i + 1];
            o[i] = pg8::cvt_pk_bf16(lo, hi);
        }
        *(uint4*)dst = make_uint4(o[0], o[1], o[2], o[3]);
    }
}

#define XB_XCNT(j)  (256  + 64 * (j))
#define XB_XSUB(j)  (1280 + 64 * (j))
#define XB_XGEN(j)  (2304 + 64 * (j))
#define XB_TOP      3328
#define XB_TOPGEN   3392
#define XCD_BAR_WORDS 3456
constexpr size_t WS_BAR = 255 * MiB + 512 * 1024;
constexpr int LDS_BARST = LDS_BYTES - 64;
__device__ __forceinline__ unsigned xb_ld(unsigned* p)              { return __hip_atomic_load(p, __ATOMIC_RELAXED, __HIP_MEMORY_SCOPE_AGENT); }
__device__ __forceinline__ unsigned xb_add(unsigned* p, unsigned v) { return __hip_atomic_fetch_add(p, v, __ATOMIC_RELAXED, __HIP_MEMORY_SCOPE_AGENT); }
__device__ __forceinline__ unsigned xb_xcc_id() { return (unsigned)__builtin_amdgcn_s_getreg((3 << 11) | 20) & 0xFu; }
__device__ __forceinline__ void gbar(unsigned* bar, volatile PG8_LAS unsigned* st, unsigned k) {
    asm volatile("s_waitcnt vmcnt(0)" ::: "memory");
    __syncthreads();
    if (threadIdx.x == 0) {
        const unsigned x = xb_xcc_id(), nloc = st[0], nx = st[1];
        const unsigned old = xb_add(&bar[XB_XSUB(x)], 1u);
        if (old + 1u == (k + 1u) * nloc) {
            __builtin_amdgcn_fence(__ATOMIC_RELEASE, "agent");
            asm volatile("s_waitcnt vmcnt(0)" ::: "memory");
            const unsigned og = xb_add(&bar[XB_TOP], 1u);
            if (og + 1u == (k + 1u) * nx) xb_add(&bar[XB_TOPGEN], 1u);
            else while (xb_ld(&bar[XB_TOPGEN]) == k) __builtin_amdgcn_s_sleep(1);
            __builtin_amdgcn_fence(__ATOMIC_ACQUIRE, "agent");
            xb_add(&bar[XB_XGEN(x)], 1u);
            asm volatile("s_waitcnt vmcnt(0)" ::: "memory");
        } else {
            while (xb_ld(&bar[XB_XGEN(x)]) == k) __builtin_amdgcn_s_sleep(1);
            __builtin_amdgcn_fence(__ATOMIC_ACQUIRE, "agent");
            asm volatile("s_waitcnt vmcnt(0)" ::: "memory");
        }
    }
    __syncthreads();
}
template <class Epi> __device__ __forceinline__ void run_gemm(PG8_LAS unsigned char* lds, const bf16_t* A, const bf16_t* Bt, int M, int N, int K, const Epi& E, int a_tile_rows = 256, int stagger = 0) {
    if (stagger) { const unsigned long long t0 = wall_clock64(), d = (unsigned long long)(((blockIdx.x >> 3) & 3) * stagger); while (wall_clock64() - t0 < d) __builtin_amdgcn_s_sleep(4); }
    pg8::Gemm g{A, Bt, M, N, K, a_tile_rows}; pg8::StaticOrder S; S.init(M, N, (int)gridDim.x, (int)blockIdx.x);
    pg8::gemm_phase<Epi, pg8::StaticOrder, false>(lds, g, S, E, nullptr);
}

__global__ void __launch_bounds__(512, 2) fwd_megakernel(Params P) {
    extern __shared__ __attribute__((aligned(16))) unsigned char smem[];
    cg::grid_group grid = cg::this_grid();
    PG8_LAS unsigned char* lds = (PG8_LAS unsigned char*)smem;
    if (threadIdx.x == 0) (void)xb_add((unsigned*)(P.ws + WS_BAR) + XB_XCNT(xb_xcc_id()), 1u);
    if (P.out == nullptr) grid.sync();
    unsigned char* ws = P.ws; unsigned char* ob = (unsigned char*)P.out;
    bf16_t* h1 = (bf16_t*)(ob + OUT_H1); bf16_t* sB = (bf16_t*)(ob + OUT_SB); bf16_t* yas = (bf16_t*)(ob + OUT_YAS);
    bf16_t* Wup = (bf16_t*)(ws + WS_WUP); bf16_t* Wdown = (bf16_t*)(ws + WS_WDOWN); bf16_t* Wout = (bf16_t*)(ws + WS_WOUT); bf16_t* Wglao = (bf16_t*)(ws + WS_GLAWO); bf16_t* Wlruo = (bf16_t*)(ws + WS_LRUWO); bf16_t* Win = (bf16_t*)(ws + WS_WIN);
    float* rowsq = (float*)(ws + WS_ROWSQ);

#ifndef PROBE_A
#define PROBE_A -1
#define PROBE_B -1
#endif
    unsigned long long tA = 0, tB = 0; unsigned bar_k = 0;
#define STAMP(k) do { if ((k) == PROBE_A) tA = wall_clock64(); if ((k) == PROBE_B) tB = wall_clock64(); } while (0)
    STAMP(0);
    rmsnorm_rows_bf16(P.in[0], P.in[1], h1);
    transpose_range<0, 1984>(P, (float*)smem, (int)blockIdx.x, (int)gridDim.x);
    transpose_range<5152, NTILES_ALL>(P, (float*)smem, (int)blockIdx.x, (int)gridDim.x);
    for (int i = blockIdx.x * blockDim.x + threadIdx.x; i < SEQ; i += gridDim.x * blockDim.x) rowsq[i] = 0.f;
    for (int i = blockIdx.x * blockDim.x + threadIdx.x; i < LW; i += gridDim.x * blockDim.x) { const float av = P.in[13][i]; ((float*)(ws + WS_SP))[i] = fmaxf(av, 0.f) + log1pf(__expf(-fabsf(av))); }
    if (threadIdx.x == 0) {
        unsigned mine, cnt; const unsigned x = xb_xcc_id();
        for (;;) { unsigned sum = 0u; mine = 0u; cnt = 0u;
            for (unsigned j = 0; j < 16; ++j) { const unsigned c = xb_ld((unsigned*)(P.ws + WS_BAR) + XB_XCNT(j)); sum += c; cnt += c > 0u ? 1u : 0u; mine = j == x ? c : mine; }
            if (sum == gridDim.x) break;
            __builtin_amdgcn_s_sleep(2); }
        ((volatile PG8_LAS unsigned*)(lds + LDS_BARST))[0] = mine; ((volatile PG8_LAS unsigned*)(lds + LDS_BARST))[1] = cnt;
    }
    __syncthreads();
    gbar((unsigned*)(P.ws + WS_BAR), (volatile PG8_LAS unsigned*)(lds + LDS_BARST), bar_k++);
    STAMP(1);
    { EpiGen<F1> E{F1{(bf16_t*)(ws + WS_Q), (bf16_t*)(ws + WS_K), (bf16_t*)(ws + WS_V), (bf16_t*)(ws + WS_G), (bf16_t*)(ws + WS_SA), sB, (bf16_t*)(ws + WS_XL), (bf16_t*)(ws + WS_GG), (float*)(ws + WS_FLOW)}};
      run_gemm(lds, h1, Win, SEQ, NP, DM, E, 256, STAG); }
    gbar((unsigned*)(P.ws + WS_BAR), (volatile PG8_LAS unsigned*)(lds + LDS_BARST), bar_k++);
    STAMP(2);
#ifdef NAIVE_GLA
    gla_naive(P, (float*)smem);
    gbar((unsigned*)(P.ws + WS_BAR), (volatile PG8_LAS unsigned*)(lds + LDS_BARST), bar_k++);
#else
    gla_pass<false>(P, lds);
    gbar((unsigned*)(P.ws + WS_BAR), (volatile PG8_LAS unsigned*)(lds + LDS_BARST), bar_k++);
    STAMP(3);
    gla_scan(P);
    transpose_range<4288, 5152>(P, (float*)smem, (int)blockIdx.x, (int)gridDim.x);
    gbar((unsigned*)(P.ws + WS_BAR), (volatile PG8_LAS unsigned*)(lds + LDS_BARST), bar_k++);
    STAMP(4);
    gla_pass<true>(P, lds);
    gbar((unsigned*)(P.ws + WS_BAR), (volatile PG8_LAS unsigned*)(lds + LDS_BARST), bar_k++);
    STAMP(5);
#endif
#ifdef NAIVE_LRU
    lru_naive(P, (float*)smem);
    gbar((unsigned*)(P.ws + WS_BAR), (volatile PG8_LAS unsigned*)(lds + LDS_BARST), bar_k++);
#else
    lru_pass1(P, lds);
    gbar((unsigned*)(P.ws + WS_BAR), (volatile PG8_LAS unsigned*)(lds + LDS_BARST), bar_k++);
    STAMP(6);
    lru_pass2(P);
    transpose_range<1984, 3520>(P, (float*)smem, (int)blockIdx.x, (int)gridDim.x);
    gbar((unsigned*)(P.ws + WS_BAR), (volatile PG8_LAS unsigned*)(lds + LDS_BARST), bar_k++);
    STAMP(7);
    lru_pass3(P);
    gbar((unsigned*)(P.ws + WS_BAR), (volatile PG8_LAS unsigned*)(lds + LDS_BARST), bar_k++);
    STAMP(8);
#endif
    { EpiGen<F2> E{F2{(const bf16_t*)(ws + WS_SA), yas}}; run_gemm(lds, (const bf16_t*)(ws + WS_G), Wglao, SEQ, DM, DM, E); }
    { EpiGen<F3> E{F3{sB, yas, (bf16_t*)(ws + WS_MERGED)}}; run_gemm(lds, (const bf16_t*)(ws + WS_HB), Wlruo, SEQ, DM, LWP, E); }
    gbar((unsigned*)(P.ws + WS_BAR), (volatile PG8_LAS unsigned*)(lds + LDS_BARST), bar_k++);
    STAMP(9);
    if (blockIdx.x == 0) for (int i = threadIdx.x; i < 2 * DM / 2; i += 512) ((unsigned*)(ws + WS_X1B))[i] = 0u;
    { E4 E{P.in[0], P.out, (bf16_t*)(ws + WS_X1B), rowsq}; run_gemm(lds, (const bf16_t*)(ws + WS_MERGED), Wout, SEQ, DM, DM, E); }
    gbar((unsigned*)(P.ws + WS_BAR), (volatile PG8_LAS unsigned*)(lds + LDS_BARST), bar_k++);
    STAMP(10);
    { E5f E{rowsq, P.in[18], P.in[19], (bf16_t*)(ws + WS_ACT), (PG8_LAS float*)(lds + XCH_OFF)}; run_gemm(lds, (const bf16_t*)(ws + WS_X1B), Wup, 65 * 256, 2 * DFF, DM, E, 254, STAG);
      transpose_in_idle_slot<3520, 4288>(P, (float*)smem, 65 * 24); }
    gbar((unsigned*)(P.ws + WS_BAR), (volatile PG8_LAS unsigned*)(lds + LDS_BARST), bar_k++);
    STAMP(14);
    { E6 E{P.out, (const bf16_t*)(ws + WS_X1B)}; run_gemm(lds, (const bf16_t*)(ws + WS_ACT), Wdown, SEQ, DM, DFF, E); }
    gbar((unsigned*)(P.ws + WS_BAR), (volatile PG8_LAS unsigned*)(lds + LDS_BARST), bar_k++);
    STAMP(15);
    rmsnorm_rows_inplace(P.out, P.in[21]);
    if (PROBE_A >= 0) { gbar((unsigned*)(P.ws + WS_BAR), (volatile PG8_LAS unsigned*)(lds + LDS_BARST), bar_k++); STAMP(16); if (blockIdx.x == 0 && threadIdx.x == 0) { const unsigned long long t0 = wall_clock64(); while (wall_clock64() - t0 < tB - tA) __builtin_amdgcn_s_sleep(8); } }
}

extern "C" void kernel_launch(void* const* d_in, const int* in_sizes, int n_in, void* d_out, int out_size, void* d_ws, size_t ws_size, hipStream_t stream) {
    static int grid_blocks = 0;
    if (grid_blocks == 0) {
        int dev = 0, cus = 0, per_cu = 0;
        hipGetDevice(&dev);
        hipDeviceGetAttribute(&cus, hipDeviceAttributeMultiprocessorCount, dev);
        if (hipFuncSetAttribute((const void*)fwd_megakernel, hipFuncAttributeMaxDynamicSharedMemorySize, LDS_BYTES) != hipSuccess) { fprintf(stderr, "hipFuncSetAttribute failed\n"); grid_blocks = -1; return; }
        if (hipOccupancyMaxActiveBlocksPerMultiprocessor(&per_cu, (const void*)fwd_megakernel, 512, LDS_BYTES) != hipSuccess || per_cu < 1) { fprintf(stderr, "occupancy query: %d\n", per_cu); per_cu = 1; }
        (void)hipGetLastError();
        grid_blocks = cus * per_cu;
        if (n_in != 22 || ws_size < 256 * MiB) { fprintf(stderr, "unexpected n_in %d / ws_size %zu\n", n_in, ws_size); }
    }
    if (grid_blocks < 0) return;
    Params p{};
    for (int i = 0; i < 22; ++i) p.in[i] = (const float*)d_in[i];
    p.out = (float*)d_out; p.ws = (unsigned char*)d_ws;
    if (hipMemsetAsync((unsigned char*)d_ws + WS_BAR, 0, XCD_BAR_WORDS * sizeof(unsigned), stream) != hipSuccess) { fprintf(stderr, "memset of barrier words failed\n"); return; }
    void* args[] = {&p};
    hipError_t e = hipLaunchCooperativeKernel((const void*)fwd_megakernel, dim3(grid_blocks), dim3(512), args, LDS_BYTES, stream);
    if (e != hipSuccess) fprintf(stderr, "cooperative launch failed: %s (grid %d)\n", hipGetErrorString(e), grid_blocks);
}
```
